# Optimizing an MI355X kernel written in HIP

```python
import math
import jax
import jax.numpy as jnp
from jax import lax
import numpy as np

D_MODEL = 1024
BATCH = 2
SEQ = 8192
DEPTH = 1
DEC_BATCH = 32
DEC_SEQ = 4
PAST_LEN = 8192
PAGE_SIZE = 128

HEAD_DIM = 64
N_HEADS = D_MODEL // HEAD_DIM
H_MOBA = N_HEADS // 2
H_NSA = N_HEADS - H_MOBA
H_NSA_KV = 2
NSA_GROUP = H_NSA // H_NSA_KV
W_MOBA = H_MOBA * HEAD_DIM
W_NSA = H_NSA * HEAD_DIM
W_NSA_KV = H_NSA_KV * HEAD_DIM
D_IN = 4 * W_MOBA + 2 * W_NSA + 6 * W_NSA_KV + 3 * H_NSA
MOBA_BLOCK = 256
MOBA_TOPK = 3
CMP_LEN = 32
CMP_STRIDE = 16
CMP_HIDDEN = 2 * HEAD_DIM
SLC_BLOCK = 64
SLC_TOPN = 16
WINDOW = 512
N_BUCKETS = 32
MAX_DISTANCE = 128
Q_BLOCK = 64
RMS_EPS = 1e-6
NEG = -1e30
FORCE = 1e9
TINY = 1e-30

kernel_name = 'hymba_moba_nsa_decoder_step'


def proj_splits():
    sizes = [W_MOBA] * 4 + [W_NSA] + [W_NSA_KV] * 6 + [3 * H_NSA, W_NSA]
    return [int(s) for s in np.cumsum(sizes)[:-1]]


def rmsnorm(x, gain):
    xf = x.astype(jnp.float32)
    inv = lax.rsqrt(jnp.mean(xf * xf, axis=-1, keepdims=True) + RMS_EPS)
    return (xf * inv).astype(x.dtype) * gain


def masked_softmax(logits, mask):
    logits = jnp.where(mask, logits.astype(jnp.float32), NEG)
    p = jnp.exp(logits - jnp.max(logits, axis=-1, keepdims=True)) * mask
    return p / jnp.maximum(jnp.sum(p, axis=-1, keepdims=True), TINY)


def t5_bucket(rel):
    n = jnp.maximum(rel, 0)
    exact = N_BUCKETS // 2
    nf = jnp.maximum(n, 1).astype(jnp.float32)
    large = exact + (jnp.log(nf / exact) / math.log(MAX_DISTANCE / exact) * (N_BUCKETS - exact)).astype(jnp.int32)
    return jnp.where(n < exact, n, jnp.minimum(large, N_BUCKETS - 1))


def project(x, c, w_ada_l, b_ada_l, gain_l, w_in_l):
    B, T, _ = x.shape
    shift, scale, gate = jnp.split(c @ w_ada_l + b_ada_l, 3, axis=-1)
    h = rmsnorm(x, gain_l) * (1.0 + scale[:, None]) + shift[:, None]
    (q_m, k_m, v_m, z_m, q_n, kc, vc, ks, vs, kw, vw, g_n, z_n) = jnp.split(h @ w_in_l, proj_splits(), axis=-1)
    heads = lambda a: a.reshape(B, T, -1, HEAD_DIM)
    gates = jax.nn.sigmoid(g_n).reshape(B, T, H_NSA, 3)
    return (gate, z_m, z_n, heads(q_m), heads(k_m), heads(v_m), heads(q_n),
            heads(kc), heads(vc), heads(ks), heads(vs), heads(kw), heads(vw), gates)


def moba_keys(k, v):
    B, L, H, Dh = k.shape
    nb = -(-L // MOBA_BLOCK)
    pad = ((0, 0), (0, nb * MOBA_BLOCK - L), (0, 0), (0, 0))
    kb = jnp.pad(k, pad).reshape(B, nb, MOBA_BLOCK, H, Dh)
    vb = jnp.pad(v, pad).reshape(B, nb, MOBA_BLOCK, H, Dh)
    kmean = jnp.mean(kb.astype(jnp.float32), axis=2).astype(k.dtype)
    return kb, vb, kmean


def moba_attend(q, qpos, kb, vb, kmean, bias_tab):
    B, Q, H, Dh = q.shape
    nb = kb.shape[1]
    cur = qpos // MOBA_BLOCK
    s = jnp.einsum('bqhd,bnhd->bhqn', q, kmean).astype(jnp.float32)
    full = jnp.arange(nb, dtype=jnp.int32)[None, :] < cur[:, None]
    top = min(MOBA_TOPK, nb)
    _, idx = lax.top_k(jnp.where(full, s, NEG), top)
    own = jnp.broadcast_to(cur[None, None, :, None], (B, H, Q, 1))
    blocks = jnp.concatenate([idx, own], axis=-1)
    ok = jnp.concatenate([idx < cur[None, None, :, None], jnp.ones_like(own, dtype=bool)], axis=-1)
    bi = jnp.arange(B)[:, None, None, None]
    hi = jnp.arange(H)[None, :, None, None]
    kg = kb[bi, blocks, :, hi]
    vg = vb[bi, blocks, :, hi]
    n = (top + 1) * MOBA_BLOCK
    logits = jnp.einsum('bqhd,bhqnkd->bhqnk', q, kg) * (HEAD_DIM ** -0.5)
    rel = qpos[None, None, :, None, None] - (blocks[..., None] * MOBA_BLOCK + jnp.arange(MOBA_BLOCK, dtype=jnp.int32))
    mask = ok[..., None] & (rel >= 0)
    hh = jnp.arange(H)[None, :, None, None, None]
    logits = logits.astype(jnp.float32) + bias_tab[hh, t5_bucket(rel)].astype(jnp.float32)
    p = masked_softmax(logits.reshape(B, H, Q, n), mask.reshape(B, H, Q, n))
    o = jnp.einsum('bhqn,bhqnd->bqhd', p.astype(vg.dtype), vg.reshape(B, H, Q, n, Dh))
    return o.reshape(B, Q, H * Dh)


def nsa_compress(rows, pe, w1, w2):
    B, L, Hk, Dh = rows.shape
    n_cmp = (L - CMP_LEN) // CMP_STRIDE + 1
    idx = jnp.arange(n_cmp)[:, None] * CMP_STRIDE + jnp.arange(CMP_LEN)[None, :]
    blk = rows[:, idx] + pe[:, None, :]
    blk = jnp.moveaxis(blk, 3, 2).reshape(B, n_cmp, Hk, CMP_LEN * Dh)
    return jax.nn.silu(blk @ w1) @ w2


def nsa_keys(kc_r, vc_r, ks_r, vs_r, pe, kw1, kw2, vw1, vw2):
    B, L, Hk, Dh = ks_r.shape
    kc = nsa_compress(kc_r, pe[0], kw1, kw2)
    vc = nsa_compress(vc_r, pe[1], vw1, vw2)
    n_cmp = kc.shape[1]
    start = jnp.arange(n_cmp, dtype=jnp.int32) * CMP_STRIDE
    cmp_end = start + (CMP_LEN - 1)
    n_slc = -(-L // SLC_BLOCK)
    bstart = jnp.arange(n_slc, dtype=jnp.int32) * SLC_BLOCK
    ov = ((start[:, None] < bstart[None, :] + SLC_BLOCK) & (cmp_end[:, None] >= bstart[None, :])).astype(jnp.float32)
    pad = ((0, 0), (0, n_slc * SLC_BLOCK - L), (0, 0), (0, 0))
    ksb = jnp.pad(ks_r, pad).reshape(B, n_slc, SLC_BLOCK, Hk, Dh)
    vsb = jnp.pad(vs_r, pad).reshape(B, n_slc, SLC_BLOCK, Hk, Dh)
    return kc, vc, cmp_end, ov, ksb, vsb


def nsa_attend(q, gates, qpos, kc, vc, cmp_end, ov, ksb, vsb, kw, vw, kw_pos, bias_tab):
    B, Q = q.shape[:2]
    G = NSA_GROUP
    sc = HEAD_DIM ** -0.5
    qg = q.reshape(B, Q, H_NSA_KV, G, HEAD_DIM)
    bt = bias_tab.reshape(H_NSA_KV, G, N_BUCKETS)
    lc = jnp.einsum('bqkgd,bnkd->bkgqn', qg, kc) * sc
    pc = masked_softmax(lc, (cmp_end[None, :] <= qpos[:, None])[None, None, None])
    o_cmp = jnp.einsum('bkgqn,bnkd->bqkgd', pc.astype(vc.dtype), vc)
    n_slc = ov.shape[1]
    imp = jnp.einsum('bkgqn,ns->bkqs', pc, ov)
    cur = qpos // SLC_BLOCK
    j = jnp.arange(n_slc, dtype=jnp.int32)[None, :]
    avail = j <= cur[:, None]
    forced = (j == 0) | (j == cur[:, None]) | (j == cur[:, None] - 1)
    imp = jnp.where(avail, jnp.where(forced, FORCE, imp), NEG)
    top = min(SLC_TOPN, n_slc)
    _, idx = lax.top_k(imp, top)
    bi = jnp.arange(B)[:, None, None, None]
    ki = jnp.arange(H_NSA_KV)[None, :, None, None]
    ks = ksb[bi, idx, :, ki]
    vs = vsb[bi, idx, :, ki]
    ls = jnp.einsum('bqkgd,bkqnsd->bkgqns', qg, ks) * sc
    rel_s = qpos[None, None, :, None, None] - (idx[..., None] * SLC_BLOCK + jnp.arange(SLC_BLOCK, dtype=jnp.int32))
    mask_s = (idx <= cur[None, None, :, None])[..., None] & (rel_s >= 0)
    kk = jnp.arange(H_NSA_KV)[None, :, None, None, None, None]
    gg = jnp.arange(G)[None, None, :, None, None, None]
    ls = ls.astype(jnp.float32) + bt[kk, gg, t5_bucket(rel_s)[:, :, None]].astype(jnp.float32)
    n = top * SLC_BLOCK
    ps = masked_softmax(ls.reshape(B, H_NSA_KV, G, Q, n), mask_s.reshape(B, H_NSA_KV, 1, Q, n))
    o_slc = jnp.einsum('bkgqn,bkqnd->bqkgd', ps.astype(vs.dtype), vs.reshape(B, H_NSA_KV, Q, n, HEAD_DIM))
    lw = jnp.einsum('bqkgd,bwkd->bkgqw', qg, kw) * sc
    rel_w = qpos[:, None] - kw_pos[None, :]
    mask_w = (rel_w >= 0) & (rel_w < WINDOW) & (kw_pos[None, :] >= 0)
    lw = lw.astype(jnp.float32) + bt[:, :, t5_bucket(rel_w)].astype(jnp.float32)
    pw = masked_softmax(lw, mask_w)
    o_win = jnp.einsum('bkgqw,bwkd->bqkgd', pw.astype(vw.dtype), vw)
    g = gates.reshape(B, Q, H_NSA_KV, G, 3)
    o = g[..., 0:1] * o_cmp + g[..., 1:2] * o_slc + g[..., 2:3] * o_win
    return o.reshape(B, Q, W_NSA)


def mix_out(x, gate, o_m, z_m, o_n, z_n, w_out_l):
    mixed = jnp.concatenate([o_m * jax.nn.silu(z_m), o_n * jax.nn.silu(z_n)], axis=-1)
    return x + gate[:, None, :] * (mixed @ w_out_l)


def prompt_layer(x, c, lp, bias_m, bias_n):
    w_ada_l, b_ada_l, gain_l, w_in_l, pe, kw1, kw2, vw1, vw2, w_out_l = lp
    B, T, _ = x.shape
    (gate, z_m, z_n, q_m, k_m, v_m, q_n, kc_r, vc_r, ks_r, vs_r, kw_r, vw_r, gates) = project(x, c, w_ada_l, b_ada_l, gain_l, w_in_l)
    kb, vb, kmean = moba_keys(k_m, v_m)
    nk = nsa_keys(kc_r, vc_r, ks_r, vs_r, pe, kw1, kw2, vw1, vw2)
    wpad = ((0, 0), (WINDOW, 0), (0, 0), (0, 0))
    kw_pad = jnp.pad(kw_r, wpad)
    vw_pad = jnp.pad(vw_r, wpad)
    nc = T // Q_BLOCK
    chunk = lambda a: jnp.moveaxis(a.reshape(B, nc, Q_BLOCK, *a.shape[2:]), 1, 0)
    pos = jnp.arange(T, dtype=jnp.int32).reshape(nc, Q_BLOCK)

    def step(args):
        qm, qn, g, p = args
        s0 = p[0]
        kw = lax.dynamic_slice_in_dim(kw_pad, s0, WINDOW + Q_BLOCK, axis=1)
        vw = lax.dynamic_slice_in_dim(vw_pad, s0, WINDOW + Q_BLOCK, axis=1)
        kw_pos = s0 - WINDOW + jnp.arange(WINDOW + Q_BLOCK, dtype=jnp.int32)
        o_m = moba_attend(qm, p, kb, vb, kmean, bias_m)
        o_n = nsa_attend(qn, g, p, *nk, kw, vw, kw_pos, bias_n)
        return o_m, o_n

    o_m, o_n = lax.map(step, (chunk(q_m), chunk(q_n), chunk(gates), pos))
    unchunk = lambda o: jnp.moveaxis(o, 0, 1).reshape(B, T, -1)
    x_new = mix_out(x, gate, unchunk(o_m), z_m, unchunk(o_n), z_n, w_out_l)
    wb = min(WINDOW, T)
    return (x_new, jnp.stack([k_m, v_m], axis=2), jnp.stack([kc_r, vc_r, ks_r, vs_r], axis=2),
            jnp.stack([kw_r, vw_r], axis=2)[:, T - wb:])


def sample_layer(x, c, cache_m, cache_n, win_state, page_table, lp, bias_m, bias_n):
    w_ada_l, b_ada_l, gain_l, w_in_l, pe, kw1, kw2, vw1, vw2, w_out_l = lp
    B, S, _ = x.shape
    P = page_table.shape[1] * cache_m.shape[1]
    (gate, z_m, z_n, q_m, k_m, v_m, q_n, kc_r, vc_r, ks_r, vs_r, kw_r, vw_r, gates) = project(x, c, w_ada_l, b_ada_l, gain_l, w_in_l)
    past_m = cache_m[page_table].reshape(B, P, 2, H_MOBA, HEAD_DIM)
    past_n = cache_n[page_table].reshape(B, P, 4, H_NSA_KV, HEAD_DIM)
    cat = lambda past, new: jnp.concatenate([past, new], axis=1)
    qpos = P + jnp.arange(S, dtype=jnp.int32)
    o_m = moba_attend(q_m, qpos, *moba_keys(cat(past_m[:, :, 0], k_m), cat(past_m[:, :, 1], v_m)), bias_m)
    nk = nsa_keys(cat(past_n[:, :, 0], kc_r), cat(past_n[:, :, 1], vc_r), cat(past_n[:, :, 2], ks_r),
                  cat(past_n[:, :, 3], vs_r), pe, kw1, kw2, vw1, vw2)
    win_all = cat(win_state, jnp.stack([kw_r, vw_r], axis=2))
    wb = win_state.shape[1]
    kw_pos = P - wb + jnp.arange(wb + S, dtype=jnp.int32)
    o_n = nsa_attend(q_n, gates, qpos, *nk, win_all[:, :, 0], win_all[:, :, 1], kw_pos, bias_n)
    x_new = mix_out(x, gate, o_m, z_m, o_n, z_n, w_out_l)
    return (x_new, jnp.stack([k_m, v_m], axis=2), jnp.stack([kc_r, vc_r, ks_r, vs_r], axis=2), win_all[:, S:])


def setup_inputs(seed: int = 0) -> dict:
    key = jax.random.key(seed)
    ks = jax.random.split(key, 24)
    n_pages = PAST_LEN // PAGE_SIZE
    used = DEC_BATCH * n_pages
    n_phys = used + max(1, used // 4)
    wb = min(WINDOW, PAST_LEN)
    nrm = lambda k, shape, s=1.0: jax.random.normal(k, shape, jnp.float32) * s
    page_table = jax.random.permutation(ks[7], n_phys)[:used].reshape(DEC_BATCH, n_pages).astype(jnp.int32)
    return {
        'x_prompt': nrm(ks[0], (BATCH, SEQ, D_MODEL)),
        'x_sample': nrm(ks[1], (DEC_BATCH, DEC_SEQ, D_MODEL)),
        'c_prompt': nrm(ks[2], (BATCH, D_MODEL)),
        'c_sample': nrm(ks[3], (DEC_BATCH, D_MODEL)),
        'cache_moba_kv': nrm(ks[4], (DEPTH, n_phys, PAGE_SIZE, 2, H_MOBA, HEAD_DIM)),
        'cache_nsa_kv': nrm(ks[5], (DEPTH, n_phys, PAGE_SIZE, 4, H_NSA_KV, HEAD_DIM)),
        'state_nsa_win': nrm(ks[6], (DEPTH, DEC_BATCH, wb, 2, H_NSA_KV, HEAD_DIM)),
        'page_table': page_table,
        'w_ada': nrm(ks[8], (DEPTH, D_MODEL, 3 * D_MODEL), 0.3 * D_MODEL ** -0.5),
        'b_ada': nrm(ks[9], (DEPTH, 3 * D_MODEL), 0.01),
        'norm_gain': 1.0 + nrm(ks[10], (DEPTH, D_MODEL), 0.01),
        'w_in': nrm(ks[11], (DEPTH, D_MODEL, D_IN), D_MODEL ** -0.5),
        'cmp_pe': nrm(ks[12], (DEPTH, 2, CMP_LEN, HEAD_DIM), 0.5),
        'cmp_k_w1': nrm(ks[13], (DEPTH, CMP_LEN * HEAD_DIM, CMP_HIDDEN), (CMP_LEN * HEAD_DIM) ** -0.5),
        'cmp_k_w2': nrm(ks[14], (DEPTH, CMP_HIDDEN, HEAD_DIM), CMP_HIDDEN ** -0.5),
        'cmp_v_w1': nrm(ks[15], (DEPTH, CMP_LEN * HEAD_DIM, CMP_HIDDEN), (CMP_LEN * HEAD_DIM) ** -0.5),
        'cmp_v_w2': nrm(ks[16], (DEPTH, CMP_HIDDEN, HEAD_DIM), CMP_HIDDEN ** -0.5),
        'w_out': nrm(ks[17], (DEPTH, D_MODEL, D_MODEL), D_MODEL ** -0.5),
        'rel_bias': nrm(ks[18], (N_BUCKETS, N_HEADS), 0.5),
        'final_gain': 1.0 + nrm(ks[19], (D_MODEL,), 0.01),
    }


def reference(x_prompt, x_sample, c_prompt, c_sample, cache_moba_kv, cache_nsa_kv, state_nsa_win, page_table,
              w_ada, b_ada, norm_gain, w_in, cmp_pe, cmp_k_w1, cmp_k_w2, cmp_v_w1, cmp_v_w2, w_out,
              rel_bias, final_gain):
    bias_m = rel_bias[:, :H_MOBA].T
    bias_n = rel_bias[:, H_MOBA:].T
    xp, xs = x_prompt, x_sample
    mkv_p, mkv_s, nkv_p, nkv_s, win_p, win_s = [], [], [], [], [], []
    for l in range(DEPTH):
        lp = (w_ada[l], b_ada[l], norm_gain[l], w_in[l], cmp_pe[l], cmp_k_w1[l], cmp_k_w2[l],
              cmp_v_w1[l], cmp_v_w2[l], w_out[l])
        xp, a, b, cw = prompt_layer(xp, c_prompt, lp, bias_m, bias_n)
        mkv_p.append(a)
        nkv_p.append(b)
        win_p.append(cw)
        xs, a, b, cw = sample_layer(xs, c_sample, cache_moba_kv[l], cache_nsa_kv[l], state_nsa_win[l],
                                    page_table, lp, bias_m, bias_n)
        mkv_s.append(a)
        nkv_s.append(b)
        win_s.append(cw)
    y_prompt = rmsnorm(xp, final_gain)
    y_sample = rmsnorm(xs, final_gain)
    moba_kv_prompt = jnp.stack(mkv_p)
    moba_kv_sample = jnp.stack(mkv_s)
    nsa_kv_prompt = jnp.stack(nkv_p)
    nsa_kv_sample = jnp.stack(nkv_s)
    win_prompt = jnp.stack(win_p)
    win_sample = jnp.stack(win_s)
    return (y_prompt, y_sample, moba_kv_prompt, moba_kv_sample, nsa_kv_prompt, nsa_kv_sample, win_prompt, win_sample)
```

```cpp
#include <hip/hip_runtime.h>
#include <stdint.h>
#include <stdio.h>

#ifndef MEGA
#define MEGA 1
#endif
#ifndef REP
#define REP -1
#endif

#define DI __device__ __forceinline__
#define LAS __attribute__((address_space(3)))

typedef __attribute__((ext_vector_type(8))) short bf16x8;
typedef __attribute__((ext_vector_type(4))) short s16x4;
typedef __attribute__((ext_vector_type(16))) float f32x16;
typedef __attribute__((ext_vector_type(4))) float f32x4;
typedef __attribute__((ext_vector_type(8))) float f32x8;
typedef __attribute__((ext_vector_type(8))) __bf16 bf8v;
typedef __attribute__((ext_vector_type(4))) __bf16 bf4v;
typedef unsigned short u16;

constexpr int NP = 16384, NS = 128, NT = NP + NS;
constexpr int DINP = 3968;
constexpr float LOG2E = 1.4426950408889634f;
constexpr size_t O_YP = 0, O_YS = 16777216, O_MKP = 16908288, O_MKS = 33685504, O_NKP = 33816576,
                 O_NKS = 42205184, O_WP = 42270720, O_WS = 42532864;
constexpr size_t al256(size_t x) { return (x + 255) & ~(size_t)255; }
constexpr size_t WS_BAR = 0;
constexpr size_t WS_CTR = 16384;
constexpr size_t WS_ZERO_BYTES = 32768;
constexpr size_t WS_MOD = 32768;
constexpr size_t WS_WTIN = al256(WS_MOD + (size_t)34 * 3072 * 4);
constexpr size_t WS_WTOUT = al256(WS_WTIN + (size_t)DINP * 1024 * 2);
constexpr size_t WS_WC1K = al256(WS_WTOUT + (size_t)1024 * 1024 * 2);
constexpr size_t WS_WC1V = al256(WS_WC1K + (size_t)128 * 2048 * 2);
constexpr size_t WS_WC2K = al256(WS_WC1V + (size_t)128 * 2048 * 2);
constexpr size_t WS_WC2V = al256(WS_WC2K + (size_t)64 * 128 * 2);
constexpr size_t WS_KMP = al256(WS_WC2V + (size_t)64 * 128 * 2);
constexpr size_t WS_KMS = al256(WS_KMP + (size_t)2 * 32 * 4 * 512 * 4);
constexpr size_t WS_H = al256(WS_KMS + (size_t)32 * 32 * 512 * 4);
constexpr size_t WS_QM = al256(WS_H + (size_t)NT * 1024 * 2);
constexpr size_t WS_ZM = al256(WS_QM + (size_t)NT * 512 * 2);
constexpr size_t WS_QN = al256(WS_ZM + (size_t)NT * 512 * 2);
constexpr size_t WS_ZN = al256(WS_QN + (size_t)NT * 512 * 2);
constexpr size_t WS_GATES = al256(WS_ZN + (size_t)NT * 512 * 2);
constexpr size_t WS_KMB = al256(WS_GATES + (size_t)NT * 24 * 4);
constexpr size_t WS_VMB = al256(WS_KMB + (size_t)2 * 8 * 8192 * 64 * 2);
constexpr size_t WS_KSB = al256(WS_VMB + (size_t)2 * 8 * 8192 * 64 * 2);
constexpr size_t WS_VSB = al256(WS_KSB + (size_t)2 * 2 * 8192 * 64 * 2);
constexpr size_t WS_KWB = al256(WS_VSB + (size_t)2 * 2 * 8192 * 64 * 2);
constexpr size_t WS_VWB = al256(WS_KWB + (size_t)2 * 2 * 8192 * 64 * 2);
constexpr size_t WS_CKB = al256(WS_VWB + (size_t)2 * 2 * 8192 * 64 * 2);
constexpr size_t WS_CVB = al256(WS_CKB + (size_t)34 * 2 * 512 * 64 * 2);
constexpr size_t WS_MIXED = al256(WS_CVB + (size_t)34 * 2 * 512 * 64 * 2);
constexpr size_t WS_XNEW = al256(WS_MIXED + (size_t)NT * 1024 * 2);
constexpr size_t WS_SEL = al256(WS_XNEW + (size_t)NT * 1024 * 4);
constexpr size_t WS_LIST = al256(WS_SEL + (size_t)2 * 8 * 8192 * 4);
constexpr size_t WS_PART = al256(WS_LIST + (size_t)2 * 8 * 32 * 8192 * 2);
constexpr size_t WS_END0 = al256(WS_PART + (size_t)2 * 8 * 8192 * 3 * 68 * 4);
constexpr size_t WS_LUTG = WS_END0;
constexpr size_t WS_END = al256(WS_LUTG + (size_t)16 * 2 * 768 * 4);
constexpr size_t WS_MCNT = WS_CTR + 4096;

constexpr int LDS_BYTES = 66560;
constexpr int NTHREADS = 256;

struct Params {
    const float *x_p, *x_s, *c_p, *c_s, *cache_m, *cache_n, *win_state;
    const int* page_table;
    const float *w_ada, *b_ada, *norm_gain, *w_in, *cmp_pe, *k_w1, *k_w2, *v_w1, *v_w2, *w_out, *rel_bias, *final_gain;
    float* out;
    unsigned char* ws;
};

DI bf16x8 cvt8(f32x4 a, f32x4 b) {
    f32x8 v = {a.x, a.y, a.z, a.w, b.x, b.y, b.z, b.w};
    return __builtin_bit_cast(bf16x8, __builtin_convertvector(v, bf8v));
}
DI uint2 cvt4(float a, float b, float c, float d) {
    f32x4 v = {a, b, c, d};
    return __builtin_bit_cast(uint2, __builtin_convertvector(v, bf4v));
}
DI u16 cvt1(float a) { __bf16 h = (__bf16)a; return __builtin_bit_cast(u16, h); }
DI float bf2f(u16 u) { return __uint_as_float((unsigned)u << 16); }
DI float fexp2(float x) { return __builtin_amdgcn_exp2f(x); }
DI float silu_f(float z) { return z / (1.f + __expf(-z)); }
DI float sigmoid_f(float z) { return 1.f / (1.f + __expf(-z)); }
DI int crow(int i, int h) { return (i & 3) + 8 * (i >> 2) + 4 * h; }
DI f32x16 mfma32(bf16x8 a, bf16x8 b, f32x16 c) { return __builtin_amdgcn_mfma_f32_32x32x16_bf16(a, b, c, 0, 0, 0); }
DI float wave_sum(float v) {
#pragma unroll
    for (int o = 1; o < 64; o <<= 1) v += __shfl_xor(v, o);
    return v;
}
DI int opaque(int v) { asm volatile("" : "+v"(v)); return v; }
DI int opaque_s(int v) { asm volatile("" : "+s"(v)); return v; }
DI f32x16 zero16() { f32x16 z; for (int i = 0; i < 16; ++i) z[i] = 0.f; return z; }
DI s16x4 tr_read(const char* p) {
    return __builtin_amdgcn_ds_read_tr16_b64_v4i16((LAS s16x4*)(LAS char*)p);
}

#define XB_TMO      128
#define XB_XCNT(j)  (256  + 64 * (j))
#define XB_XSUB(j)  (1280 + 64 * (j))
#define XB_XGEN(j)  (2304 + 64 * (j))
#define XB_TOP      3328
#define XB_TOPGEN   3392
#define XCD_BAR_WORDS 3456
#define XB_SPIN_CAP (1u << 22)

DI unsigned xb_ld(unsigned* p)              { return __hip_atomic_load(p, __ATOMIC_RELAXED, __HIP_MEMORY_SCOPE_AGENT); }
DI unsigned xb_add(unsigned* p, unsigned v) { return __hip_atomic_fetch_add(p, v, __ATOMIC_RELAXED, __HIP_MEMORY_SCOPE_AGENT); }
DI unsigned xb_xcc_id() { return (unsigned)__builtin_amdgcn_s_getreg((3 << 11) | 20) & 0xFu; }
#define XB_SPIN(cond, bar) do { unsigned _sp = 0; while (cond) { __builtin_amdgcn_s_sleep(1); \
    if ((++_sp & 255u) == 0u) { if (xb_ld(&(bar)[XB_TMO])) break; if (_sp > XB_SPIN_CAP) { atomicAdd(&(bar)[XB_TMO], 1u); break; } } } } while (0)

struct XcdBarrier { unsigned* bar; unsigned x; volatile LAS unsigned* st; };

DI XcdBarrier xcd_barrier_post(unsigned* bar, volatile LAS unsigned* st) {
    XcdBarrier b; b.bar = bar; b.x = xb_xcc_id(); b.st = st;
    if (threadIdx.x == 0) (void)xb_add(&bar[XB_XCNT(b.x)], 1u);
    return b;
}
DI void xcd_barrier_complete(unsigned* bar, unsigned x, unsigned& nloc, unsigned& nx) {
    const unsigned G = gridDim.x * gridDim.y * gridDim.z;
    unsigned sum, cnt, mine, sp = 0u;
    for (;;) {
        sum = 0u; cnt = 0u; mine = 0u;
#pragma unroll
        for (unsigned j = 0; j < 16; ++j) { const unsigned c = xb_ld(&bar[XB_XCNT(j)]); sum += c; cnt += (c > 0u) ? 1u : 0u; mine = (j == x) ? c : mine; }
        if (sum == G) break;
        __builtin_amdgcn_s_sleep(1);
        if ((++sp & 255u) == 0u) { if (xb_ld(&bar[XB_TMO])) break; if (sp > XB_SPIN_CAP) { atomicAdd(&bar[XB_TMO], 1u); break; } }
    }
    nloc = mine > 0u ? mine : 1u; nx = cnt > 0u ? cnt : 1u;
}
DI void xcd_barrier(const XcdBarrier& b) {
    asm volatile("s_waitcnt vmcnt(0)" ::: "memory");
    __syncthreads();
    if (threadIdx.x == 0) {
        unsigned* bar = b.bar;
        __builtin_amdgcn_s_waitcnt(0);
        unsigned nloc = b.st[0], nx = b.st[1];
        if (nloc == 0u) { xcd_barrier_complete(bar, b.x, nloc, nx); b.st[0] = nloc; b.st[1] = nx; }
        const unsigned old = xb_add(&bar[XB_XSUB(b.x)], 1u);
        const unsigned gen = old / nloc;
        if (old + 1u == (gen + 1u) * nloc) {
            __builtin_amdgcn_fence(__ATOMIC_RELEASE, "agent");
            asm volatile("s_waitcnt vmcnt(0)" ::: "memory");
            const unsigned og = xb_add(&bar[XB_TOP], 1u);
            const unsigned tg = og / nx;
            if (og + 1u == (tg + 1u) * nx) xb_add(&bar[XB_TOPGEN], 1u);
            else XB_SPIN(xb_ld(&bar[XB_TOPGEN]) == tg, bar);
            __builtin_amdgcn_fence(__ATOMIC_ACQUIRE, "agent");
            xb_add(&bar[XB_XGEN(b.x)], 1u);
            asm volatile("s_waitcnt vmcnt(0)" ::: "memory");
        } else {
            XB_SPIN(xb_ld(&bar[XB_XGEN(b.x)]) == gen, bar);
            __builtin_amdgcn_fence(__ATOMIC_ACQUIRE, "agent");
            asm volatile("s_waitcnt vmcnt(0)" ::: "memory");
        }
    }
    __syncthreads();
}

DI int t5_bucket(int n) {
    if (n < 16) return n;
    int b = 16;
    b += n >= 19; b += n >= 21; b += n >= 24; b += n >= 27; b += n >= 31; b += n >= 35; b += n >= 40; b += n >= 46;
    b += n >= 52; b += n >= 59; b += n >= 67; b += n >= 77; b += n >= 87; b += n >= 99; b += n >= 113;
    return b;
}

constexpr int LW = 768;
DI int perm_in(int n) { return n < 3328 ? n : (n < 3352 ? 3840 + (n - 3328) : n - 24); }

DI void transpose_item(const float* __restrict__ W, int K, int N, u16* __restrict__ WT, int kt, int nt, bool perm, char* sm) {
    float* scr = (float*)sm;
    const int t = opaque(threadIdx.x);
    const int k0 = kt * 64, n0 = nt * 64;
#pragma unroll 4
    for (int i = 0; i < 16; ++i) {
        const int kk = (t >> 6) + 4 * i, n = n0 + (t & 63);
        scr[kk * 65 + (t & 63)] = (n < N) ? W[(size_t)(k0 + kk) * N + n] : 0.f;
    }
    __syncthreads();
    const int nl = t >> 2, kc = (t & 3) * 16, nn = n0 + nl;
    if (nn < N) {
        const int np = perm ? perm_in(nn) : nn;
        float v[16];
#pragma unroll
        for (int j = 0; j < 16; ++j) v[j] = scr[(kc + j) * 65 + nl];
        f32x4 a = {v[0], v[1], v[2], v[3]}, b = {v[4], v[5], v[6], v[7]}, c = {v[8], v[9], v[10], v[11]}, d = {v[12], v[13], v[14], v[15]};
        bf16x8* dst = (bf16x8*)(WT + (size_t)np * K + k0 + kc);
        dst[0] = cvt8(a, b); dst[1] = cvt8(c, d);
    }
    __syncthreads();
}

DI void kmean_item(const float* __restrict__ base, const int* __restrict__ pt, int b, int n, float* __restrict__ outp, char* sm) {
    float* scr = (float*)sm;
    const int t = opaque(threadIdx.x), lane = t & 63, w = t >> 6;
    f32x4 a0 = {0.f, 0.f, 0.f, 0.f}, a1 = {0.f, 0.f, 0.f, 0.f};
#pragma unroll
    for (int hf = 0; hf < 2; ++hf) {
        const int pos0 = n * 256 + hf * 128;
        const size_t r0 = pt ? (size_t)pt[b * 64 + (pos0 >> 7)] * 128 : (size_t)b * 8192 + pos0;
        const float* rp = base + (r0 + w) * 1024 + lane * 4;
#pragma unroll 4
        for (int rr = 0; rr < 32; ++rr) {
            a0 += __builtin_nontemporal_load((const f32x4*)(rp + (size_t)rr * 4096));
            a1 += __builtin_nontemporal_load((const f32x4*)(rp + (size_t)rr * 4096 + 256));
        }
    }
    *(f32x4*)(scr + w * 512 + lane * 4) = a0;
    *(f32x4*)(scr + w * 512 + 256 + lane * 4) = a1;
    __syncthreads();
#pragma unroll
    for (int j = 0; j < 2; ++j) {
        const int col = t + 256 * j;
        outp[col] = (scr[col] + scr[512 + col] + scr[1024 + col] + scr[1536 + col]) * (1.f / 256.f);
    }
    __syncthreads();
}

DI void ada_item(const Params& p, int item, char* sm) {
    float* scr = (float*)sm;
    float* mod = (float*)(p.ws + WS_MOD);
    const int t = opaque(threadIdx.x), cl = t & 15, kg = t >> 4, col0 = item * 16;
    float acc[36];
#pragma unroll
    for (int i = 0; i < 36; ++i) acc[i] = 0.f;
    for (int pass = 0; pass < 4; ++pass) {
#pragma unroll
        for (int bb = 0; bb < 34; ++bb) scr[t * 36 + bb] = bb < 2 ? p.c_p[bb * 1024 + pass * 256 + t] : p.c_s[(bb - 2) * 1024 + pass * 256 + t];
        if (pass == 0) { scr[t * 36 + 34] = 0.f; scr[t * 36 + 35] = 0.f; }
        __syncthreads();
        float wv[16];
#pragma unroll
        for (int kk = 0; kk < 16; ++kk) wv[kk] = p.w_ada[(size_t)(pass * 256 + kk * 16 + kg) * 3072 + col0 + cl];
#pragma unroll
        for (int kk = 0; kk < 16; ++kk) {
            const float* cr = scr + (kk * 16 + kg) * 36;
#pragma unroll
            for (int j = 0; j < 9; ++j) {
                const f32x4 c4 = *(const f32x4*)(cr + 4 * j);
                acc[4 * j] += c4.x * wv[kk]; acc[4 * j + 1] += c4.y * wv[kk]; acc[4 * j + 2] += c4.z * wv[kk]; acc[4 * j + 3] += c4.w * wv[kk];
            }
        }
        __syncthreads();
    }
#pragma unroll
    for (int bb = 0; bb < 34; ++bb) scr[(kg * 34 + bb) * 16 + cl] = acc[bb];
    __syncthreads();
    for (int o = t; o < 34 * 16; o += 256) {
        const int bb = o >> 4, c2 = o & 15;
        float s = p.b_ada[col0 + c2];
#pragma unroll
        for (int g = 0; g < 16; ++g) s += scr[(g * 34 + bb) * 16 + c2];
        mod[bb * 3072 + col0 + c2] = s;
    }
    __syncthreads();
}

constexpr int P0_KMS = 1024, P0_TWIN = 16 * 61, P0_TWOUT = 256, P0_W1 = 64, P0_W2 = 2, P0_ADA = 192, P0_WCP = 128, P0_PAD = 13, P0_LUT = 16;
constexpr int P0_ITEMS = P0_KMS + P0_TWIN + P0_TWOUT + 2 * P0_W1 + 2 * P0_W2 + P0_ADA + P0_WCP + P0_PAD + P0_LUT;

DI void phase0(const Params& p, char* sm, int msk = 15) {
    unsigned* ctr = (unsigned*)(p.ws + WS_CTR) + 256;
    int* slot = (int*)(sm + LDS_BYTES - 16);
    for (;;) {
        if (threadIdx.x == 0) *slot = (int)__hip_atomic_fetch_add(ctr, 1u, __ATOMIC_RELAXED, __HIP_MEMORY_SCOPE_AGENT);
        __syncthreads();
        const int it = *slot;
        __syncthreads();
        if (it >= P0_ITEMS) break;
        const int t = opaque(threadIdx.x);
        int r = it;
        if (r < P0_ADA) { if (msk & 1) ada_item(p, r, sm); continue; } r -= P0_ADA;
        if (r < P0_KMS) { if (msk & 2) kmean_item(p.cache_m, p.page_table, r >> 5, r & 31, (float*)(p.ws + WS_KMS) + (size_t)r * 512, sm); continue; } r -= P0_KMS;
        if (r < P0_TWIN + P0_TWOUT + 2 * P0_W1 + 2 * P0_W2) { if (!(msk & 4)) continue; } else if (!(msk & 8)) continue;
        if (r < P0_TWIN) { transpose_item(p.w_in, 1024, 3864, (u16*)(p.ws + WS_WTIN), r / 61, r % 61, true, sm); continue; } r -= P0_TWIN;
        if (r < P0_TWOUT) { transpose_item(p.w_out, 1024, 1024, (u16*)(p.ws + WS_WTOUT), r >> 4, r & 15, false, sm); continue; } r -= P0_TWOUT;
        if (r < P0_W1) { transpose_item(p.k_w1, 2048, 128, (u16*)(p.ws + WS_WC1K), r >> 1, r & 1, false, sm); continue; } r -= P0_W1;
        if (r < P0_W1) { transpose_item(p.v_w1, 2048, 128, (u16*)(p.ws + WS_WC1V), r >> 1, r & 1, false, sm); continue; } r -= P0_W1;
        if (r < P0_W2) { transpose_item(p.k_w2, 128, 64, (u16*)(p.ws + WS_WC2K), r, 0, false, sm); continue; } r -= P0_W2;
        if (r < P0_W2) { transpose_item(p.v_w2, 128, 64, (u16*)(p.ws + WS_WC2V), r, 0, false, sm); continue; } r -= P0_W2;
        if (r < P0_WCP) {
            const int b = r >> 2, q = r & 3;
            const f32x4* src = (const f32x4*)(p.win_state + ((size_t)b * 512 + 4) * 256) + q * 8128;
            f32x4* dst = (f32x4*)(p.out + O_WS + (size_t)b * 512 * 256) + q * 8128;
            for (int i0 = 0; i0 < 8128; i0 += 1024) {
                f32x4 v0, v1, v2, v3;
                const int ia = i0 + t, ib = ia + 256, ic = ia + 512, id = ia + 768;
                const int ja = ia < 8128 ? ia : 8127, jb = ib < 8128 ? ib : 8127, jc = ic < 8128 ? ic : 8127, jd = id < 8128 ? id : 8127;
                v0 = __builtin_nontemporal_load(src + ja); v1 = __builtin_nontemporal_load(src + jb);
                v2 = __builtin_nontemporal_load(src + jc); v3 = __builtin_nontemporal_load(src + jd);
                dst[ja] = v0; dst[jb] = v1; dst[jc] = v2; dst[jd] = v3;
            }
            continue;
        } r -= P0_WCP;
        if (r >= P0_PAD) {
            const int hd = r - P0_PAD;
            float* lg = (float*)(p.ws + WS_LUTG) + (size_t)hd * 2 * LW;
            for (int i = t; i < 2 * LW; i += 256) {
                const int var = i >= LW, rel = (var ? i - LW : i) - 128;
                const float bias = p.rel_bias[t5_bucket(rel < 0 ? 0 : (rel > 127 ? 127 : rel)) * 16 + hd] * LOG2E;
                lg[i] = (rel < 0 || (var && rel >= 512)) ? -1e30f : bias;
            }
            continue;
        }
        {
            uint4* dst = (uint4*)(p.ws + WS_WTIN + (size_t)3864 * 2048) + (size_t)r * 1024;
            const uint4 z = {0u, 0u, 0u, 0u};
            for (int i = t; i < 1024; i += 256) dst[i] = z;
        }
    }
}

DI void phase1(const Params& p, char* sm) {
    const int tt_ = opaque(threadIdx.x), lane = tt_ & 63, w = tt_ >> 6;
    const float* mod = (const float*)(p.ws + WS_MOD);
    u16* H = (u16*)(p.ws + WS_H);
    for (int row = blockIdx.x * 4 + w; row < NT; row += gridDim.x * 4) {
        const float* xr = row < NP ? p.x_p + (size_t)row * 1024 : p.x_s + (size_t)(row - NP) * 1024;
        const int mb = row < NP ? (row >> 13) : 2 + ((row - NP) >> 2);
        f32x4 v[4]; float ss = 0.f;
#pragma unroll
        for (int j = 0; j < 4; ++j) { v[j] = *(const f32x4*)(xr + lane * 4 + 256 * j); ss += v[j].x * v[j].x + v[j].y * v[j].y + v[j].z * v[j].z + v[j].w * v[j].w; }
        ss = wave_sum(ss);
        const float inv = rsqrtf(ss * (1.f / 1024.f) + 1e-6f);
#pragma unroll
        for (int j = 0; j < 4; ++j) {
            const int col = lane * 4 + 256 * j;
            const f32x4 g = *(const f32x4*)(p.norm_gain + col);
            const f32x4 sh = *(const f32x4*)(mod + mb * 3072 + col);
            const f32x4 sc = *(const f32x4*)(mod + mb * 3072 + 1024 + col);
            const float h0 = (v[j].x * inv) * g.x * (1.f + sc.x) + sh.x;
            const float h1 = (v[j].y * inv) * g.y * (1.f + sc.y) + sh.y;
            const float h2 = (v[j].z * inv) * g.z * (1.f + sc.z) + sh.z;
            const float h3 = (v[j].w * inv) * g.w * (1.f + sc.w) + sh.w;
            *(uint2*)(H + (size_t)row * 1024 + col) = cvt4(h0, h1, h2, h3);
        }
    }
}

struct TileSrc {
    const float* base; const int* pt; const float* base_new;
    int P, ld, newbs, kcol, vcol, b, posoff, maxsrc;
};
DI const float* ts_row(const TileSrc& s, int kpos) {
    int sp = kpos - s.posoff; sp = sp < 0 ? 0 : (sp > s.maxsrc ? s.maxsrc : sp);
    if (sp < s.P) {
        const size_t r = s.pt ? (size_t)s.pt[s.b * 64 + (sp >> 7)] * 128 + (sp & 127) : (size_t)s.b * s.P + sp;
        return s.base + r * s.ld;
    }
    return s.base_new + ((size_t)s.b * s.newbs + (sp - s.P)) * s.ld;
}

struct ALoadBf16 {
    const u16* A; int lda; int m0;
    struct Raw { bf16x8 v[4]; };
    static DI int kmap(int kt) { return kt; }
    DI void load(Raw& R, int kt) const {
        const int t = opaque(threadIdx.x), lrow = t >> 3, lch = t & 7;
#pragma unroll
        for (int i = 0; i < 4; ++i) R.v[i] = *(const bf16x8*)(A + (size_t)(m0 + lrow + 32 * i) * lda + kt * 64 + lch * 8);
    }
    DI void cvt(const Raw& R, bf16x8 (&o)[4], int) const {
#pragma unroll
        for (int i = 0; i < 4; ++i) o[i] = R.v[i];
    }
};
struct ALoadCmp {
    const float* base; const float* pe; int col; int pg0[2], pg1[2], pos0[2];
    struct Raw { f32x4 a[4], b[4]; };
    static DI int kmap(int kt) { return (kt >> 1) + 16 * (kt & 1); }
    DI void init(const float* base_, const int* pt, int b, int i0, int kv, const float* pe_) {
        base = base_; pe = pe_; col = kv * 128;
        const int lrow = opaque(threadIdx.x) >> 3;
#pragma unroll
        for (int j = 0; j < 2; ++j) {
            int blk = i0 + lrow + 32 * j; blk = blk > 510 ? 510 : blk;
            pos0[j] = 16 * blk;
            const int pg = pos0[j] >> 7, pgn = pg < 63 ? pg + 1 : 63;
            pg0[j] = pt ? pt[b * 64 + pg] : b * 64 + pg;
            pg1[j] = pt ? pt[b * 64 + pgn] : b * 64 + pgn;
        }
    }
    DI void load(Raw& R, int kt) const {
        const int lch = opaque(threadIdx.x) & 7;
#pragma unroll
        for (int j = 0; j < 2; ++j) {
            const int pos = pos0[j] + kt;
            const int pg = (pos >> 7) == (pos0[j] >> 7) ? pg0[j] : pg1[j];
            const float* rp = base + ((size_t)pg * 128 + (pos & 127)) * 512 + col + lch * 8;
            R.a[j] = *(const f32x4*)rp; R.b[j] = *(const f32x4*)(rp + 4);
            R.a[j + 2] = *(const f32x4*)(rp + 64); R.b[j + 2] = *(const f32x4*)(rp + 68);
        }
    }
    DI void cvt(const Raw& R, bf16x8 (&o)[4], int kt) const {
        const int lch = opaque(threadIdx.x) & 7;
        const f32x4 pe0 = *(const f32x4*)(pe + kt * 64 + lch * 8), pe1 = *(const f32x4*)(pe + kt * 64 + lch * 8 + 4);
#pragma unroll
        for (int i = 0; i < 4; ++i) o[i] = cvt8(R.a[i] + pe0, R.b[i] + pe1);
    }
};

template <class AL> struct GemmRegs { typename AL::Raw RA0, RA1; bf16x8 RB0[4], RB1[4]; };
template <class AL>
DI void gemm_mainloop(f32x16 (&acc)[2][2], GemmRegs<AL>& G, bool pre, const AL& al, const u16* __restrict__ Bt, int ldb, int n0, int nk, char* sm,
                      bool has_next, const AL& aln, int n0n) {
    const int t = opaque(threadIdx.x), lane = t & 63, w = t >> 6;
    const int wm = w >> 1, wn = w & 1, r = lane & 31, h = lane >> 5;
    const int lrow = t >> 3, lch = t & 7;
    typename AL::Raw& RA0 = G.RA0; typename AL::Raw& RA1 = G.RA1;
    bf16x8 (&RB0)[4] = G.RB0; bf16x8 (&RB1)[4] = G.RB1;
    const u16* bp = Bt + (size_t)(n0 + lrow) * ldb + lch * 8;
    const u16* bpn = Bt + (size_t)(n0n + lrow) * ldb + lch * 8;
    auto loadB = [&](bf16x8 (&rb)[4], int kt) {
#pragma unroll
        for (int i = 0; i < 4; ++i) rb[i] = *(const bf16x8*)(bp + (size_t)(32 * i) * ldb + kt * 64);
    };
    auto loadBn = [&](bf16x8 (&rb)[4], int kt) {
#pragma unroll
        for (int i = 0; i < 4; ++i) rb[i] = *(const bf16x8*)(bpn + (size_t)(32 * i) * ldb + kt * 64);
    };
    auto store = [&](const typename AL::Raw& RA, const bf16x8 (&rb)[4], int kt, char* dA) {
        bf16x8 ra[4];
        al.cvt(RA, ra, AL::kmap(kt));
#pragma unroll
        for (int i = 0; i < 4; ++i) {
            const int row = lrow + 32 * i;
            const int off = row * 128 + ((lch ^ ((row >> 1) & 7)) << 4);
            *(bf16x8*)(dA + off) = ra[i];
            *(bf16x8*)(dA + 16384 + off) = rb[i];
        }
    };
    auto compute = [&](const char* cA) {
        const char* cB = cA + 16384;
        bf16x8 a[2][2], b[2][2];
        auto rd = [&](int set, int ks) {
#pragma unroll
            for (int mi = 0; mi < 2; ++mi) { const int row = wm * 64 + mi * 32 + r; a[set][mi] = *(const bf16x8*)(cA + row * 128 + (((2 * ks + h) ^ ((row >> 1) & 7)) << 4)); }
#pragma unroll
            for (int ni = 0; ni < 2; ++ni) { const int row = wn * 64 + ni * 32 + r; b[set][ni] = *(const bf16x8*)(cB + row * 128 + (((2 * ks + h) ^ ((row >> 1) & 7)) << 4)); }
        };
        auto mm = [&](int set) {
#pragma unroll
            for (int mi = 0; mi < 2; ++mi)
#pragma unroll
                for (int ni = 0; ni < 2; ++ni) acc[mi][ni] = mfma32(a[set][mi], b[set][ni], acc[mi][ni]);
        };
        rd(0, 0); rd(1, 1);
        __builtin_amdgcn_sched_barrier(0);
        mm(0); rd(0, 2);
        __builtin_amdgcn_sched_barrier(0);
        mm(1); rd(1, 3);
        __builtin_amdgcn_sched_barrier(0);
        mm(0); mm(1);
    };
    char* buf0 = sm; char* buf1 = sm + 32768;
    if (!pre) {
        al.load(RA0, AL::kmap(0)); loadB(RB0, AL::kmap(0));
        al.load(RA1, AL::kmap(1)); loadB(RB1, AL::kmap(1));
    }
    store(RA0, RB0, 0, buf0);
    __syncthreads();
    if (2 < nk) { al.load(RA0, AL::kmap(2)); loadB(RB0, AL::kmap(2)); }
    for (int kt = 0; kt < nk; kt += 2) {
        compute(buf0);
        store(RA1, RB1, kt + 1, buf1);
        if (kt + 3 < nk) { al.load(RA1, AL::kmap(kt + 3)); loadB(RB1, AL::kmap(kt + 3)); }
        else if (has_next) { aln.load(RA1, AL::kmap(1)); loadBn(RB1, AL::kmap(1)); }
        __syncthreads();
        compute(buf1);
        if (kt + 2 < nk) {
            store(RA0, RB0, kt + 2, buf0);
            if (kt + 4 < nk) { al.load(RA0, AL::kmap(kt + 4)); loadB(RB0, AL::kmap(kt + 4)); }
            else if (has_next) { aln.load(RA0, AL::kmap(0)); loadBn(RB0, AL::kmap(0)); }
        }
        __syncthreads();
    }
}

template <int LD, int MODE>
DI void epi_store(const f32x16 (&acc)[2][2], float* fb, u16* bb) {
#pragma unroll
    for (int mi = 0; mi < 2; ++mi)
#pragma unroll
        for (int ni = 0; ni < 2; ++ni)
#pragma unroll
            for (int i = 0; i < 16; ++i) {
                const int off = (mi * 32 + (i & 3) + 8 * (i >> 2)) * LD + ni * 32;
                const float v = acc[mi][ni][i];
                if (MODE == 0) fb[off] = v;
                else if (MODE == 1) bb[off] = cvt1(v);
                else bb[off] = cvt1(silu_f(v));
            }
}

DI void gemm1_tile(const Params& p, GemmRegs<ALoadBf16>& G, bool pre, int tm, int tn, bool has_next, int tmn, int tnn, char* sm) {
    f32x16 acc[2][2];
#pragma unroll
    for (int a = 0; a < 2; ++a)
#pragma unroll
        for (int b = 0; b < 2; ++b) acc[a][b] = zero16();
    ALoadBf16 al{(const u16*)(p.ws + WS_H), 1024, tm * 128};
    ALoadBf16 aln{(const u16*)(p.ws + WS_H), 1024, tmn * 128};
    gemm_mainloop(acc, G, pre, al, (const u16*)(p.ws + WS_WTIN), 1024, tn * 128, 16, sm, has_next, aln, tnn * 128);
    const int t_ = opaque(threadIdx.x), lane = t_ & 63, w = t_ >> 6, wm = w >> 1, wn = w & 1, r = lane & 31, h = lane >> 5;
    const bool smp = tm == 128;
    const size_t rloc = (size_t)(smp ? 0 : tm * 128) + wm * 64 + 4 * h;
    const size_t rall = (size_t)tm * 128 + wm * 64 + 4 * h;
    const int cl = wn * 64 + r;
    if (tn < 4) epi_store<512, 1>(acc, nullptr, (u16*)(p.ws + WS_QM) + rall * 512 + tn * 128 + cl);
    else if (tn < 12) {
        epi_store<1024, 0>(acc, p.out + (smp ? O_MKS : O_MKP) + rloc * 1024 + (tn - 4) * 128 + cl, nullptr);
        if (!smp) {
            u16* dst = (u16*)(p.ws + (tn < 8 ? WS_KMB : WS_VMB)) + (((size_t)(tm >> 6) * 8 + 2 * (tn & 3) + wn) * 8192 + (tm & 63) * 128 + wm * 64 + 4 * h) * 64 + r;
            epi_store<64, 1>(acc, nullptr, dst);
            if (tn < 8) {
                float* kp = (float*)(p.ws + WS_KMP) + ((((size_t)(tm >> 6) * 32 + ((tm & 63) >> 1)) * 4 + (tm & 1) * 2 + wm) * 512) + (tn - 4) * 128 + cl;
#pragma unroll
                for (int ni = 0; ni < 2; ++ni) {
                    float cs = 0.f;
#pragma unroll
                    for (int mi = 0; mi < 2; ++mi)
#pragma unroll
                        for (int i = 0; i < 16; ++i) cs += acc[mi][ni][i];
                    cs += __shfl_xor(cs, 32);
                    if (h == 0) kp[ni * 32] = cs;
                }
            }
        }
    }
    else if (tn < 16) epi_store<512, 2>(acc, nullptr, (u16*)(p.ws + WS_ZM) + rall * 512 + (tn - 12) * 128 + cl);
    else if (tn < 20) epi_store<512, 1>(acc, nullptr, (u16*)(p.ws + WS_QN) + rall * 512 + (tn - 16) * 128 + cl);
    else if (tn < 24) {
        epi_store<512, 0>(acc, p.out + (smp ? O_NKS : O_NKP) + rloc * 512 + (tn - 20) * 128 + cl, nullptr);
        if (!smp && tn >= 22) {
            u16* dst = (u16*)(p.ws + (tn == 22 ? WS_KSB : WS_VSB)) + (((size_t)(tm >> 6) * 2 + wn) * 8192 + (tm & 63) * 128 + wm * 64 + 4 * h) * 64 + r;
            epi_store<64, 1>(acc, nullptr, dst);
        }
    }
    else if (tn < 26) {
        const int coff = (tn - 24) * 128 + cl;
        if (smp) {
            float* fb = p.out + O_WS + ((size_t)(wm * 16 + h) * 512 + 508) * 256 + coff;
#pragma unroll
            for (int mi = 0; mi < 2; ++mi)
#pragma unroll
                for (int ni = 0; ni < 2; ++ni)
#pragma unroll
                    for (int i = 0; i < 16; ++i) fb[((mi * 8 + 2 * (i >> 2)) * 512 + (i & 3)) * 256 + ni * 32] = acc[mi][ni][i];
        } else {
            u16* dst = (u16*)(p.ws + (tn == 24 ? WS_KWB : WS_VWB)) + (((size_t)(tm >> 6) * 2 + wn) * 8192 + (tm & 63) * 128 + wm * 64 + 4 * h) * 64 + r;
            epi_store<64, 1>(acc, nullptr, dst);
            if ((tm & 63) >= 60)
                epi_store<256, 0>(acc, p.out + O_WP + ((size_t)(tm >> 6) * 512 + ((tm & 63) - 60) * 128 + wm * 64 + 4 * h) * 256 + coff, nullptr);
        }
    }
    else if (tn < 30) epi_store<512, 2>(acc, nullptr, (u16*)(p.ws + WS_ZN) + rall * 512 + (tn - 26) * 128 + cl);
    else {
        if (wn == 0 && r < 24) {
            float* gb = (float*)(p.ws + WS_GATES) + rall * 24 + r;
#pragma unroll
            for (int mi = 0; mi < 2; ++mi)
#pragma unroll
                for (int i = 0; i < 16; ++i) gb[(mi * 32 + (i & 3) + 8 * (i >> 2)) * 24] = sigmoid_f(acc[mi][0][i]);
        }
    }
}

DI void gemm2_tile(const Params& p, GemmRegs<ALoadBf16>& G, bool pre, int tm, int tn, bool has_next, int tmn, int tnn, char* sm) {
    f32x16 acc[2][2];
#pragma unroll
    for (int a = 0; a < 2; ++a)
#pragma unroll
        for (int b = 0; b < 2; ++b) acc[a][b] = zero16();
    ALoadBf16 al{(const u16*)(p.ws + WS_MIXED), 1024, tm * 128};
    ALoadBf16 aln{(const u16*)(p.ws + WS_MIXED), 1024, tmn * 128};
    gemm_mainloop(acc, G, pre, al, (const u16*)(p.ws + WS_WTOUT), 1024, tn * 128, 16, sm, has_next, aln, tnn * 128);
    const int t_ = opaque(threadIdx.x), lane = t_ & 63, w = t_ >> 6, wm = w >> 1, wn = w & 1, r = lane & 31, h = lane >> 5;
    const bool smp = tm == 128;
    const float* mod = (const float*)(p.ws + WS_MOD);
    const int col = tn * 128 + wn * 64 + r;
    const size_t rloc = (size_t)(smp ? 0 : tm * 128) + wm * 64 + 4 * h;
    const float* xb = (smp ? p.x_s : p.x_p) + rloc * 1024 + col;
    float* ob = (float*)(p.ws + WS_XNEW) + ((size_t)tm * 128 + wm * 64 + 4 * h) * 1024 + col;
    const float* gb = mod + (size_t)(smp ? 2 + wm * 16 + h : (tm >> 6)) * 3072 + 2048 + col;
#pragma unroll
    for (int mi = 0; mi < 2; ++mi)
#pragma unroll
        for (int ni = 0; ni < 2; ++ni) {
            float xv[16], gv[16];
#pragma unroll
            for (int i = 0; i < 16; ++i) {
                const int off = (mi * 32 + (i & 3) + 8 * (i >> 2)) * 1024 + ni * 32;
                xv[i] = __builtin_nontemporal_load(xb + off);
                gv[i] = smp ? gb[(mi * 8 + 2 * (i >> 2)) * 3072 + ni * 32] : gb[ni * 32];
            }
#pragma unroll
            for (int i = 0; i < 16; ++i) {
                const int off = (mi * 32 + (i & 3) + 8 * (i >> 2)) * 1024 + ni * 32;
                ob[off] = xv[i] + gv[i] * acc[mi][ni][i];
            }
        }
}

DI void compress_item(const Params& p, bool dec, int kv, int b, int it8, char* sm) {
    f32x16 acc[2][2];
#pragma unroll
    for (int a = 0; a < 2; ++a)
#pragma unroll
        for (int c = 0; c < 2; ++c) acc[a][c] = zero16();
    ALoadCmp al;
    al.init(dec ? p.cache_n : p.out + O_NKP, dec ? p.page_table : nullptr, b, it8 * 64, kv, p.cmp_pe + kv * 2048);
    GemmRegs<ALoadCmp> G;
    gemm_mainloop(acc, G, false, al, (const u16*)(p.ws + (kv ? WS_WC1V : WS_WC1K)), 2048, 0, 32, sm, false, al, 0);
    const int t_ = opaque(threadIdx.x), lane = t_ & 63, w = t_ >> 6, wm = w >> 1, wn = w & 1, r = lane & 31, h = lane >> 5;
#pragma unroll
    for (int mi = 0; mi < 2; ++mi)
#pragma unroll
        for (int ni = 0; ni < 2; ++ni) {
            const int col = wn * 64 + ni * 32 + r;
#pragma unroll
            for (int i = 0; i < 16; ++i) {
                const int row = wm * 64 + mi * 32 + crow(i, h);
                *(u16*)(sm + row * 256 + ((((col >> 3) ^ (row & 15))) << 4) + (col & 7) * 2) = cvt1(silu_f(acc[mi][ni][i]));
            }
        }
    __syncthreads();
    f32x16 o2[2] = {zero16(), zero16()};
    const u16* w2t = (const u16*)(p.ws + (kv ? WS_WC2V : WS_WC2K));
    const int arow = 32 * w + r;
#pragma unroll
    for (int ks = 0; ks < 8; ++ks) {
        const bf16x8 a = *(const bf16x8*)(sm + arow * 256 + (((2 * ks + h) ^ (arow & 15)) << 4));
#pragma unroll
        for (int ni = 0; ni < 2; ++ni) {
            const bf16x8 bb = *(const bf16x8*)(w2t + (size_t)(ni * 32 + r) * 128 + 16 * ks + 8 * h);
            o2[ni] = mfma32(a, bb, o2[ni]);
        }
    }
    u16* cmp = (u16*)(p.ws + (kv ? WS_CVB : WS_CKB)) + ((size_t)((dec ? 2 + b : b) * 2 + (w >> 1)) * 512) * 64;
#pragma unroll
    for (int ni = 0; ni < 2; ++ni)
#pragma unroll
        for (int i = 0; i < 16; ++i) {
            const int blk = it8 * 64 + 32 * (w & 1) + crow(i, h);
            if (blk <= 510) cmp[(size_t)blk * 64 + ni * 32 + r] = cvt1(o2[ni][i]);
        }
    __syncthreads();
}

struct Flash { f32x16 o0, o1; float m, l; };
DI void flash_init(Flash& st) { st.o0 = zero16(); st.o1 = zero16(); st.m = -1e20f; st.l = 0.f; }

struct TileRegs { f32x4 k[4], v[4]; };
DI void tile_issue(TileRegs& R, const TileSrc& s, int pos0) {
    const int t = threadIdx.x;
    const float* rp = ts_row(s, pos0 + (t >> 2));
    const f32x4* kp = (const f32x4*)(rp + s.kcol + (t & 3) * 16);
    const f32x4* vp = (const f32x4*)(rp + s.vcol + (t & 3) * 16);
#pragma unroll
    for (int j = 0; j < 4; ++j) { R.k[j] = kp[j]; R.v[j] = vp[j]; }
}
DI void tile_store(const TileRegs& R, char* kbuf, char* vbuf) {
    const int t = threadIdx.x, key = t >> 2, q4 = t & 3, sw = (key >> 1) & 7;
    *(bf16x8*)(kbuf + key * 128 + (((2 * q4) ^ sw) << 4)) = cvt8(R.k[0], R.k[1]);
    *(bf16x8*)(kbuf + key * 128 + (((2 * q4 + 1) ^ sw) << 4)) = cvt8(R.k[2], R.k[3]);
    *(bf16x8*)(vbuf + key * 128 + (2 * q4) * 16) = cvt8(R.v[0], R.v[1]);
    *(bf16x8*)(vbuf + key * 128 + (2 * q4 + 1) * 16) = cvt8(R.v[2], R.v[3]);
}

constexpr int IMPLD = 132;

template <int MASK, bool NEAR, int PASS>
DI void flash_tile(Flash& st, const bf16x8 (&qf)[4], const char* kbuf, const char* vbuf, int pos0, int qpos, bool on,
                   const float* lut, float bfar, float* imp_row, float rinv) {
    const int lane = threadIdx.x & 63, r = lane & 31, h = lane >> 5;
    f32x16 s[2] = {zero16(), zero16()};
#pragma unroll
    for (int ks = 0; ks < 4; ++ks) {
        const int ka = r * 128 + (((2 * ks + h) ^ ((r >> 1) & 7)) << 4);
        const bf16x8 a0 = *(const bf16x8*)(kbuf + ka);
        const bf16x8 a1 = *(const bf16x8*)(kbuf + 4096 + ka);
        s[0] = mfma32(a0, qf[ks], s[0]);
        s[1] = mfma32(a1, qf[ks], s[1]);
    }
    constexpr float c1 = 0.125f * LOG2E;
    float alpha = 1.f;
    float rs = 0.f;
    if (!NEAR) {
        const float bc = MASK == 2 ? 0.f : bfar;
        float mref;
        if (PASS != 2) {
            float mr = s[0][0];
#pragma unroll
            for (int i = 1; i < 16; ++i) mr = fmaxf(mr, s[0][i]);
#pragma unroll
            for (int i = 0; i < 16; ++i) mr = fmaxf(mr, s[1][i]);
            float mx = on ? mr * c1 + bc : -1e30f;
            mx = fmaxf(mx, __shfl_xor(mx, 32));
            const float mnew = fmaxf(st.m, mx);
            alpha = fexp2(st.m - mnew);
            st.m = mnew;
            mref = mnew;
        } else mref = st.m;
        float bm = on ? bc - mref : -1e30f;
        if (PASS == 2) bm = on ? bm + __log2f(rinv) : -1e30f;
#pragma unroll
        for (int tt = 0; tt < 2; ++tt)
#pragma unroll
            for (int i = 0; i < 16; ++i) { const float pv = fexp2(s[tt][i] * c1 + bm); s[tt][i] = pv; rs += pv; }
    } else {
        float mx = -1e30f;
        if (MASK == 2) {
            const int dq = opaque(((qpos - 31) >> 4) - pos0 - 4 * h);
            const int oni = on ? 1 : 0;
#pragma unroll
            for (int tt = 0; tt < 2; ++tt)
#pragma unroll
                for (int i = 0; i < 16; ++i) {
                    const int rel = dq - (32 * tt + (i & 3) + 8 * (i >> 2));
                    float x = s[tt][i] * c1;
                    x = ((int)(rel >= 0) & oni) ? x : -1e30f;
                    s[tt][i] = x;
                    mx = fmaxf(mx, x);
                }
        } else {
            int dq = qpos - pos0 - 4 * h;
            dq = dq > 639 ? 639 : dq; dq = dq < -65 ? -65 : dq;
            dq = on ? dq : -65;
            const float* lp = lut + opaque(dq);
#pragma unroll
            for (int tt = 0; tt < 2; ++tt)
#pragma unroll
                for (int i = 0; i < 16; ++i) {
                    const float x = s[tt][i] * c1 + lp[128 - (32 * tt + (i & 3) + 8 * (i >> 2))];
                    s[tt][i] = x;
                    mx = fmaxf(mx, x);
                }
        }
        float mref;
        if (PASS != 2) {
            mx = fmaxf(mx, __shfl_xor(mx, 32));
            const float mnew = fmaxf(st.m, mx);
            alpha = fexp2(st.m - mnew);
            st.m = mnew;
            mref = mnew;
        } else mref = st.m;
#pragma unroll
        for (int tt = 0; tt < 2; ++tt)
#pragma unroll
            for (int i = 0; i < 16; ++i) {
                float pv = fexp2(s[tt][i] - mref);
                if (PASS == 2) pv *= rinv;
                s[tt][i] = pv; rs += pv;
            }
    }
    if (PASS != 2) {
        rs += __shfl_xor(rs, 32);
        st.l = st.l * alpha + rs;
    }
    f32x16 ia = zero16();
    if (PASS != 1) {
        if (PASS == 0) {
#pragma unroll
            for (int i = 0; i < 16; ++i) { st.o0[i] *= alpha; st.o1[i] *= alpha; }
        }
        const int G = lane >> 4, i16 = lane & 15, q = i16 >> 2, pp = i16 & 3;
        const char* vb = vbuf + (4 * (G >> 1) + q) * 128 + (16 * (G & 1) + 4 * pp) * 2;
#pragma unroll
        for (int tt = 0; tt < 2; ++tt)
#pragma unroll
            for (int ss = 0; ss < 2; ++ss) {
                f32x4 pa = {s[tt][8 * ss], s[tt][8 * ss + 1], s[tt][8 * ss + 2], s[tt][8 * ss + 3]};
                f32x4 pb2 = {s[tt][8 * ss + 4], s[tt][8 * ss + 5], s[tt][8 * ss + 6], s[tt][8 * ss + 7]};
                const bf16x8 pfrag = cvt8(pa, pb2);
                const char* vk = vb + (32 * tt + 16 * ss) * 128;
                if (PASS == 2) {
                    const int d = opaque((lane & 31) - h) - (8 * tt + 4 * ss);
                    const unsigned one2 = 0x3F803F80u, oneh = 0x3F800000u;
                    const uint4 ov = {d == 0 ? one2 : 0u, d == 0 ? one2 : (d == 1 ? oneh : 0u), d == 2 ? one2 : 0u, d == 2 ? one2 : (d == 3 ? oneh : 0u)};
                    ia = mfma32(__builtin_bit_cast(bf16x8, ov), pfrag, ia);
                }
                {
                    const s16x4 lo = tr_read(vk), hi = tr_read(vk + 8 * 128);
                    const bf16x8 va = __builtin_shufflevector(lo, hi, 0, 1, 2, 3, 4, 5, 6, 7);
                    st.o0 = mfma32(va, pfrag, st.o0);
                }
                {
                    const s16x4 lo = tr_read(vk + 64), hi = tr_read(vk + 8 * 128 + 64);
                    const bf16x8 va = __builtin_shufflevector(lo, hi, 0, 1, 2, 3, 4, 5, 6, 7);
                    st.o1 = mfma32(va, pfrag, st.o1);
                }
            }
    }
    if (PASS == 2) {
        float* dst = imp_row + (pos0 >> 2) + 4 * h;
        const bool wr = on && (lane & 3) == 0;
#pragma unroll
        for (int i = 0; i < 9; ++i) {
            float v = ia[i];
            v += __int_as_float(__builtin_amdgcn_update_dpp(0, __float_as_int(v), 0xB1, 0xf, 0xf, true));
            v += __int_as_float(__builtin_amdgcn_update_dpp(0, __float_as_int(v), 0x4E, 0xf, 0xf, true));
            if (wr && (i < 8 || h == 0)) dst[(i & 3) + 8 * (i >> 2)] += v;
        }
    }
}

struct OnFn {
    int kind; bool qvalid; unsigned long long lo, hi; int cur;
    DI bool operator()(int pos0) const {
        if (kind == 0) return qvalid;
        if (kind == 1) { const int blk = pos0 >> 8; return qvalid && (blk == cur || ((lo >> blk) & 1ull)); }
        const int j = pos0 >> 6;
        if (j >= 128) return qvalid;
        const unsigned long long x = j < 64 ? lo : hi;
        return qvalid && ((x >> (j & 63)) & 1ull) != 0ull;
    }
};

template <int MASK, int PASS>
DI void tile_step(Flash& st, const bf16x8 (&qf)[4], const char* kbuf, const char* vbuf, int pos0, int qpos, int qmin_w, int qmax_w,
                  const OnFn& onfn, const float* lut, float bfar, float* imp_row, float rinv) {
    const bool on = onfn(pos0);
    if (__any(on)) {
        bool farc;
        if (MASK == 0) farc = pos0 + 63 + 113 <= qmin_w;
        else if (MASK == 1) farc = (pos0 + 63 + 113 <= qmin_w) && (qmax_w - pos0 < 512);
        else farc = 16 * (pos0 + 63) + 31 <= qmin_w;
        if (farc) flash_tile<MASK, false, PASS>(st, qf, kbuf, vbuf, pos0, qpos, on, lut, bfar, imp_row, rinv);
        else flash_tile<MASK, true, PASS>(st, qf, kbuf, vbuf, pos0, qpos, on, lut, bfar, imp_row, rinv);
    }
}

template <int MASK, int PASS>
DI void run_tiles(Flash& st, const bf16x8 (&qf)[4], const TileSrc& src, const int* list, int n, char* kvbuf, int qpos,
                  int qmin_w, int qmax_w, const OnFn onfn, const float* lut, float bfar, float* imp_row, float rinv) {
    TileRegs R;
    if (n > 0) tile_issue(R, src, list[0]);
    for (int i = 0; i < n; ++i) {
        char* kbuf = kvbuf + (i & 1) * 16384; char* vbuf = kbuf + 8192;
        tile_store(R, kbuf, vbuf);
        __syncthreads();
        const int pos0 = list[i];
        if (i + 1 < n) tile_issue(R, src, list[i + 1]);
        tile_step<MASK, PASS>(st, qf, kbuf, vbuf, pos0, qpos, qmin_w, qmax_w, onfn, lut, bfar, imp_row, rinv);
    }
    __syncthreads();
}

struct BSrc { const u16* k; const u16* v; int maxpos; };
struct TileRegsB { bf16x8 k[2], v[2]; };
DI void tileb_issue(TileRegsB& R, const BSrc& s, int pos0) {
    const int t = threadIdx.x, c = t & 7;
    int r0 = pos0 + (t >> 3), r1 = r0 + 32;
    r0 = r0 < 0 ? 0 : (r0 > s.maxpos ? s.maxpos : r0);
    r1 = r1 < 0 ? 0 : (r1 > s.maxpos ? s.maxpos : r1);
    R.k[0] = *(const bf16x8*)(s.k + (size_t)r0 * 64 + c * 8); R.k[1] = *(const bf16x8*)(s.k + (size_t)r1 * 64 + c * 8);
    R.v[0] = *(const bf16x8*)(s.v + (size_t)r0 * 64 + c * 8); R.v[1] = *(const bf16x8*)(s.v + (size_t)r1 * 64 + c * 8);
}
DI void tileb_store(const TileRegsB& R, char* kbuf, char* vbuf) {
    const int t = threadIdx.x, key = t >> 3, c = t & 7, sw = (key >> 1) & 7;
    *(bf16x8*)(kbuf + key * 128 + ((c ^ sw) << 4)) = R.k[0];
    *(bf16x8*)(kbuf + 4096 + key * 128 + ((c ^ sw) << 4)) = R.k[1];
    *(bf16x8*)(vbuf + key * 128 + c * 16) = R.v[0];
    *(bf16x8*)(vbuf + 4096 + key * 128 + c * 16) = R.v[1];
}
template <int MASK, int PASS>
DI void run_tiles_b(Flash& st, const bf16x8 (&qf)[4], const BSrc& src, const int* list, int n, char* kvbuf, int qpos,
                    int qmin_w, int qmax_w, const OnFn onfn, const float* lut, float bfar, float* imp_row, float rinv) {
    TileRegsB RA, RB;
    if (n > 0) tileb_issue(RA, src, list[0]);
    if (n > 1) tileb_issue(RB, src, list[1]);
    for (int i = 0; i < n; i += 2) {
        {
            tileb_store(RA, kvbuf, kvbuf + 8192);
            __syncthreads();
            const int pos0 = list[i];
            if (i + 2 < n) tileb_issue(RA, src, list[i + 2]);
            tile_step<MASK, PASS>(st, qf, kvbuf, kvbuf + 8192, pos0, qpos, qmin_w, qmax_w, onfn, lut, bfar, imp_row, rinv);
        }
        if (i + 1 < n) {
            tileb_store(RB, kvbuf + 16384, kvbuf + 24576);
            __syncthreads();
            const int pos0 = list[i + 1];
            if (i + 3 < n) tileb_issue(RB, src, list[i + 3]);
            tile_step<MASK, PASS>(st, qf, kvbuf + 16384, kvbuf + 24576, pos0, qpos, qmin_w, qmax_w, onfn, lut, bfar, imp_row, rinv);
        }
    }
    __syncthreads();
}

constexpr int SM_KV = 0;
constexpr int SM_LIST = 32768;
constexpr int SM_LUT = 33792;
constexpr int SM_MISC = 46080;
constexpr int SM_SEL = 46336;
constexpr int SM_BIG = 46848;

DI void moba_item(const Params& p, char* sm, bool dec, int b, int hd, int qt) {
    const int t = opaque(threadIdx.x), lane = t & 63, w = t >> 6, c = lane & 31, h = lane >> 5;
    const int q0 = dec ? 8192 : qt * 128, nq = dec ? 4 : 128;
    const int qi = 32 * w + c, qic = qi < nq ? qi : nq - 1;
    const bool qvalid = qi < nq;
    const int qpos = q0 + qic;
    const size_t row = dec ? (size_t)NP + b * 4 + qic : (size_t)b * 8192 + qpos;
    const int cur = dec ? 32 : (q0 >> 8);
    int* list = (int*)(sm + SM_LIST);
    float* lut = (float*)(sm + SM_LUT);
    unsigned* misc = (unsigned*)(sm + SM_MISC);
    char* kmh = sm + SM_BIG; char* kml = sm + SM_BIG + 4096;

    bf16x8 qf[4];
    {
        const u16* qrow = (const u16*)(p.ws + WS_QM) + row * 512 + hd * 64;
#pragma unroll
        for (int ks = 0; ks < 4; ++ks) qf[ks] = *(const bf16x8*)(qrow + 16 * ks + 8 * h);
    }
    for (int i = t; i < LW; i += 256) lut[i] = ((const float*)(p.ws + WS_LUTG))[(size_t)hd * 2 * LW + i];
    {
        const int n = t >> 3, d0 = (t & 7) * 8;
        f32x4 a = {0.f, 0.f, 0.f, 0.f}, bq = a;
        if (n < cur) {
            const float* src = (const float*)(p.ws + WS_KMS) + ((size_t)b * 32 + n) * 512 + hd * 64 + d0;
            a = *(const f32x4*)src; bq = *(const f32x4*)(src + 4);
        }
        const bf16x8 hi = cvt8(a, bq);
        f32x4 ra, rb;
        ra.x = a.x - bf2f((u16)hi[0]); ra.y = a.y - bf2f((u16)hi[1]); ra.z = a.z - bf2f((u16)hi[2]); ra.w = a.w - bf2f((u16)hi[3]);
        rb.x = bq.x - bf2f((u16)hi[4]); rb.y = bq.y - bf2f((u16)hi[5]); rb.z = bq.z - bf2f((u16)hi[6]); rb.w = bq.w - bf2f((u16)hi[7]);
        *(bf16x8*)(kmh + n * 128 + d0 * 2) = hi;
        *(bf16x8*)(kml + n * 128 + d0 * 2) = cvt8(ra, rb);
    }
    if (t == 0) misc[0] = 0u;
    __syncthreads();
    f32x16 sc = zero16();
#pragma unroll
    for (int ks = 0; ks < 4; ++ks) {
        const bf16x8 ah = *(const bf16x8*)(kmh + c * 128 + (16 * ks + 8 * h) * 2);
        const bf16x8 al = *(const bf16x8*)(kml + c * 128 + (16 * ks + 8 * h) * 2);
        sc = mfma32(ah, qf[ks], sc);
        sc = mfma32(al, qf[ks], sc);
    }
    float v1 = -3e38f, v2 = -3e38f, v3 = -3e38f; int n1 = 99, n2 = 99, n3 = 99;
#pragma unroll
    for (int i = 0; i < 16; ++i) {
        const int n = crow(i, h);
        const float v = n < cur ? sc[i] : -3e38f;
        if (v > v1) { v3 = v2; n3 = n2; v2 = v1; n2 = n1; v1 = v; n1 = n; }
        else if (v > v2) { v3 = v2; n3 = n2; v2 = v; n2 = n; }
        else if (v > v3) { v3 = v; n3 = n; }
    }
    {
        const float pv[3] = {__shfl_xor(v1, 32), __shfl_xor(v2, 32), __shfl_xor(v3, 32)};
        const int pn[3] = {__shfl_xor(n1, 32), __shfl_xor(n2, 32), __shfl_xor(n3, 32)};
#pragma unroll
        for (int k = 0; k < 3; ++k) {
            const float v = pv[k]; const int n = pn[k];
            if (v > v1 || (v == v1 && n < n1)) { v3 = v2; n3 = n2; v2 = v1; n2 = n1; v1 = v; n1 = n; }
            else if (v > v2 || (v == v2 && n < n2)) { v3 = v2; n3 = n2; v2 = v; n2 = n; }
            else if (v > v3 || (v == v3 && n < n3)) { v3 = v; n3 = n; }
        }
    }
    unsigned sel = 0u;
    if (n1 < cur) sel |= 1u << n1;
    if (n2 < cur) sel |= 1u << n2;
    if (n3 < cur) sel |= 1u << n3;
    if (!qvalid) sel = 0u;
    {
        unsigned u = sel;
#pragma unroll
        for (int o = 1; o < 64; o <<= 1) u |= (unsigned)__shfl_xor((int)u, o);
        if (lane == 0) atomicOr(&misc[0], u);
    }
    __syncthreads();
    if (t == 0) {
        const unsigned U = misc[0];
        int n = 0;
        for (int blk = 0; blk <= cur; ++blk)
            if (blk == cur || ((U >> blk) & 1u))
                for (int sub = 0; sub < 4; ++sub) { const int pos0 = blk * 256 + sub * 64; if (pos0 <= q0 + nq - 1) list[n++] = pos0; }
        list[159] = n;
    }
    __syncthreads();
    const int ntile = list[159];
    TileSrc src;
    src.base = dec ? p.cache_m : p.out + O_MKP; src.pt = dec ? p.page_table : nullptr; src.base_new = p.out + O_MKS;
    src.P = 8192; src.ld = 1024; src.newbs = 4; src.kcol = hd * 64; src.vcol = 512 + hd * 64; src.b = b; src.posoff = 0;
    src.maxsrc = dec ? 8195 : 8191;
    Flash st; flash_init(st);
    const int qmin_w = q0 + (32 * w < nq ? 32 * w : nq - 1), qmax_w = q0 + (32 * w + 31 < nq ? 32 * w + 31 : nq - 1);
    const float bfar = lut[128 + 127];
    const OnFn onf{1, qvalid, (unsigned long long)sel, 0ull, cur};
    if (dec) run_tiles<0, 0>(st, qf, src, list, ntile, sm + SM_KV, qpos, qmin_w, qmax_w, onf, lut, bfar, nullptr, 0.f);
    else {
        BSrc bs{(const u16*)(p.ws + WS_KMB) + (size_t)(b * 8 + hd) * 8192 * 64, (const u16*)(p.ws + WS_VMB) + (size_t)(b * 8 + hd) * 8192 * 64, 8191};
        run_tiles_b<0, 0>(st, qf, bs, list, ntile, sm + SM_KV, qpos, qmin_w, qmax_w, onf, lut, bfar, nullptr, 0.f);
    }
    if (qvalid) {
        const float rl = 1.f / fmaxf(st.l, 1e-30f);
        const u16* zrow = (const u16*)(p.ws + WS_ZM) + row * 512 + hd * 64;
        u16* mrow = (u16*)(p.ws + WS_MIXED) + row * 1024 + hd * 64;
#pragma unroll
        for (int a = 0; a < 4; ++a) {
            const int d0 = 8 * a + 4 * h;
            const uint2 z0 = *(const uint2*)(zrow + d0), z1 = *(const uint2*)(zrow + 32 + d0);
            *(uint2*)(mrow + d0) = cvt4(st.o0[4 * a] * rl * bf2f(z0.x & 0xffff), st.o0[4 * a + 1] * rl * bf2f(z0.x >> 16),
                                        st.o0[4 * a + 2] * rl * bf2f(z0.y & 0xffff), st.o0[4 * a + 3] * rl * bf2f(z0.y >> 16));
            *(uint2*)(mrow + 32 + d0) = cvt4(st.o1[4 * a] * rl * bf2f(z1.x & 0xffff), st.o1[4 * a + 1] * rl * bf2f(z1.x >> 16),
                                             st.o1[4 * a + 2] * rl * bf2f(z1.y & 0xffff), st.o1[4 * a + 3] * rl * bf2f(z1.y >> 16));
        }
    }
    __syncthreads();
}

DI void moba_sel_item(const Params& p, char* sm, int b, int hd, int qt) {
    const int t = opaque(threadIdx.x), lane = t & 63, w = t >> 6, c = lane & 31, h = lane >> 5;
    const int q0 = qt * 128, q = q0 + 32 * w + c, cur = q0 >> 8;
    const size_t row = (size_t)b * 8192 + q;
    char* kmh = sm + SM_BIG; char* kml = sm + SM_BIG + 4096;
    unsigned* hist = (unsigned*)(sm + SM_MISC);
    unsigned* basep = (unsigned*)(sm + SM_MISC) + 32;
    unsigned* selg = (unsigned*)(p.ws + WS_SEL) + (size_t)(b * 8 + hd) * 8192;
    if (cur == 0) { if (h == 0) selg[q] = 0u; return; }
    bf16x8 qf[4];
    {
        const u16* qrow = (const u16*)(p.ws + WS_QM) + row * 512 + hd * 64;
#pragma unroll
        for (int ks = 0; ks < 4; ++ks) qf[ks] = *(const bf16x8*)(qrow + 16 * ks + 8 * h);
    }
    {
        const int n = t >> 3, d0 = (t & 7) * 8;
        f32x4 a = {0.f, 0.f, 0.f, 0.f}, bq = a;
        if (n < cur) {
            const float* src = (const float*)(p.ws + WS_KMP) + ((size_t)b * 32 + n) * 4 * 512 + hd * 64 + d0;
            a = (*(const f32x4*)src + *(const f32x4*)(src + 512)) + (*(const f32x4*)(src + 1024) + *(const f32x4*)(src + 1536));
            bq = (*(const f32x4*)(src + 4) + *(const f32x4*)(src + 516)) + (*(const f32x4*)(src + 1028) + *(const f32x4*)(src + 1540));
            a *= (1.f / 256.f); bq *= (1.f / 256.f);
        }
        const bf16x8 hi = cvt8(a, bq);
        f32x4 ra, rb;
        ra.x = a.x - bf2f((u16)hi[0]); ra.y = a.y - bf2f((u16)hi[1]); ra.z = a.z - bf2f((u16)hi[2]); ra.w = a.w - bf2f((u16)hi[3]);
        rb.x = bq.x - bf2f((u16)hi[4]); rb.y = bq.y - bf2f((u16)hi[5]); rb.z = bq.z - bf2f((u16)hi[6]); rb.w = bq.w - bf2f((u16)hi[7]);
        *(bf16x8*)(kmh + n * 128 + d0 * 2) = hi;
        *(bf16x8*)(kml + n * 128 + d0 * 2) = cvt8(ra, rb);
    }
    if (t < 32) hist[t] = 0u;
    __syncthreads();
    f32x16 sc = zero16();
#pragma unroll
    for (int ks = 0; ks < 4; ++ks) {
        const bf16x8 ah = *(const bf16x8*)(kmh + c * 128 + (16 * ks + 8 * h) * 2);
        const bf16x8 al = *(const bf16x8*)(kml + c * 128 + (16 * ks + 8 * h) * 2);
        sc = mfma32(ah, qf[ks], sc);
        sc = mfma32(al, qf[ks], sc);
    }
    float v1 = -3e38f, v2 = -3e38f, v3 = -3e38f; int n1 = 99, n2 = 99, n3 = 99;
#pragma unroll
    for (int i = 0; i < 16; ++i) {
        const int n = crow(i, h);
        const float v = n < cur ? sc[i] : -3e38f;
        if (v > v1) { v3 = v2; n3 = n2; v2 = v1; n2 = n1; v1 = v; n1 = n; }
        else if (v > v2) { v3 = v2; n3 = n2; v2 = v; n2 = n; }
        else if (v > v3) { v3 = v; n3 = n; }
    }
    {
        const float pv0 = __shfl_xor(v1, 32), pv1 = __shfl_xor(v2, 32), pv2 = __shfl_xor(v3, 32);
        const int pn0 = __shfl_xor(n1, 32), pn1 = __shfl_xor(n2, 32), pn2 = __shfl_xor(n3, 32);
#pragma unroll
        for (int k = 0; k < 3; ++k) {
            const float v = k == 0 ? pv0 : (k == 1 ? pv1 : pv2); const int n = k == 0 ? pn0 : (k == 1 ? pn1 : pn2);
            if (v > v1 || (v == v1 && n < n1)) { v3 = v2; n3 = n2; v2 = v1; n2 = n1; v1 = v; n1 = n; }
            else if (v > v2 || (v == v2 && n < n2)) { v3 = v2; n3 = n2; v2 = v; n2 = n; }
            else if (v > v3 || (v == v3 && n < n3)) { v3 = v; n3 = n; }
        }
    }
    unsigned sel = 0u;
    if (n1 < cur) sel |= 1u << n1;
    if (n2 < cur) sel |= 1u << n2;
    if (n3 < cur) sel |= 1u << n3;
    unsigned r1 = 0u, r2 = 0u, r3 = 0u;
    if (h == 0) {
        selg[q] = sel;
        if (n1 < cur) r1 = atomicAdd(&hist[n1], 1u);
        if (n2 < cur) r2 = atomicAdd(&hist[n2], 1u);
        if (n3 < cur) r3 = atomicAdd(&hist[n3], 1u);
    }
    __syncthreads();
    unsigned* mcnt = (unsigned*)(p.ws + WS_MCNT) + (b * 8 + hd) * 32;
    if (t < 32) basep[t] = hist[t] ? __hip_atomic_fetch_add(&mcnt[t], hist[t], __ATOMIC_RELAXED, __HIP_MEMORY_SCOPE_AGENT) : 0u;
    __syncthreads();
    if (h == 0) {
        u16* lst = (u16*)(p.ws + WS_LIST) + (size_t)(b * 8 + hd) * 32 * 8192;
        if (n1 < cur) lst[(size_t)n1 * 8192 + basep[n1] + r1] = (u16)q;
        if (n2 < cur) lst[(size_t)n2 * 8192 + basep[n2] + r2] = (u16)q;
        if (n3 < cur) lst[(size_t)n3 * 8192 + basep[n3] + r3] = (u16)q;
    }
    __syncthreads();
}

DI void moba_gather_item(const Params& p, char* sm, int b, int hd, int n, int chunk, int cnt) {
    const int t = opaque(threadIdx.x), lane = t & 63, w = t >> 6, c = lane & 31, h = lane >> 5;
    int* list = (int*)(sm + SM_LIST);
    float* lut = (float*)(sm + SM_LUT);
    const int e = chunk * 128 + 32 * w + c;
    const bool qvalid = e < cnt;
    const u16* lst = (const u16*)(p.ws + WS_LIST) + ((size_t)(b * 8 + hd) * 32 + n) * 8192;
    const int q = lst[qvalid ? e : cnt - 1];
    const size_t row = (size_t)b * 8192 + q;
    bf16x8 qf[4];
    {
        const u16* qrow = (const u16*)(p.ws + WS_QM) + row * 512 + hd * 64;
#pragma unroll
        for (int ks = 0; ks < 4; ++ks) qf[ks] = *(const bf16x8*)(qrow + 16 * ks + 8 * h);
    }
    for (int i = t; i < LW; i += 256) lut[i] = ((const float*)(p.ws + WS_LUTG))[(size_t)hd * 2 * LW + i];
    if (t < 4) list[t] = n * 256 + t * 64;
    __syncthreads();
    int qmin_w = qvalid ? q : 0x7fffffff;
#pragma unroll
    for (int o = 1; o < 64; o <<= 1) { const int x = __shfl_xor(qmin_w, o); qmin_w = x < qmin_w ? x : qmin_w; }
    const float bfar = lut[128 + 127];
    Flash st; flash_init(st);
    const OnFn onf{0, qvalid, 0ull, 0ull, 0};
    const BSrc bs{(const u16*)(p.ws + WS_KMB) + (size_t)(b * 8 + hd) * 8192 * 64, (const u16*)(p.ws + WS_VMB) + (size_t)(b * 8 + hd) * 8192 * 64, 8191};
    run_tiles_b<0, 0>(st, qf, bs, list, 4, sm + SM_KV, q, qmin_w, 0, onf, lut, bfar, nullptr, 0.f);
    if (qvalid) {
        const unsigned sel = ((const unsigned*)(p.ws + WS_SEL))[(size_t)(b * 8 + hd) * 8192 + q];
        const int slot = __popc(sel & ((1u << n) - 1u));
        float* pp = (float*)(p.ws + WS_PART) + (((size_t)(b * 8 + hd) * 8192 + q) * 3 + slot) * 68;
        if (h == 0) { pp[0] = st.m; pp[1] = st.l; }
#pragma unroll
        for (int a = 0; a < 4; ++a) {
            f32x4 v0 = {st.o0[4 * a], st.o0[4 * a + 1], st.o0[4 * a + 2], st.o0[4 * a + 3]};
            f32x4 v1 = {st.o1[4 * a], st.o1[4 * a + 1], st.o1[4 * a + 2], st.o1[4 * a + 3]};
            *(f32x4*)(pp + 4 + 8 * a + 4 * h) = v0; *(f32x4*)(pp + 4 + 32 + 8 * a + 4 * h) = v1;
        }
    }
    __syncthreads();
}

DI void moba_own_item(const Params& p, char* sm, int b, int hd, int qt) {
    const int t = opaque(threadIdx.x), lane = t & 63, w = t >> 6, c = lane & 31, h = lane >> 5;
    int* list = (int*)(sm + SM_LIST);
    float* lut = (float*)(sm + SM_LUT);
    const int q0 = qt * 128, q = q0 + 32 * w + c, cur = q0 >> 8;
    const size_t row = (size_t)b * 8192 + q;
    bf16x8 qf[4];
    {
        const u16* qrow = (const u16*)(p.ws + WS_QM) + row * 512 + hd * 64;
#pragma unroll
        for (int ks = 0; ks < 4; ++ks) qf[ks] = *(const bf16x8*)(qrow + 16 * ks + 8 * h);
    }
    for (int i = t; i < LW; i += 256) lut[i] = ((const float*)(p.ws + WS_LUTG))[(size_t)hd * 2 * LW + i];
    const int ntile = ((q0 + 127) >> 6) - cur * 4 + 1;
    if (t < 4) list[t] = cur * 256 + t * 64;
    __syncthreads();
    const float bfar = lut[128 + 127];
    Flash st; flash_init(st);
    const OnFn onf{0, true, 0ull, 0ull, 0};
    const BSrc bs{(const u16*)(p.ws + WS_KMB) + (size_t)(b * 8 + hd) * 8192 * 64, (const u16*)(p.ws + WS_VMB) + (size_t)(b * 8 + hd) * 8192 * 64, 8191};
    run_tiles_b<0, 0>(st, qf, bs, list, ntile, sm + SM_KV, q, q0 + 32 * w, 0, onf, lut, bfar, nullptr, 0.f);
    {
        const unsigned sel = ((const unsigned*)(p.ws + WS_SEL))[(size_t)(b * 8 + hd) * 8192 + q];
        const int ns = __popc(sel);
        const float* pp = (const float*)(p.ws + WS_PART) + ((size_t)(b * 8 + hd) * 8192 + q) * 3 * 68;
        const float pm0 = ns > 0 ? pp[0] : -1e20f, pm1 = ns > 1 ? pp[68] : -1e20f, pm2 = ns > 2 ? pp[136] : -1e20f;
        const float pl0 = pp[1], pl1 = pp[69], pl2 = pp[137];
        const float M = fmaxf(fmaxf(st.m, pm0), fmaxf(pm1, pm2));
        const float f = fexp2(st.m - M), f0 = ns > 0 ? fexp2(pm0 - M) : 0.f, f1 = ns > 1 ? fexp2(pm1 - M) : 0.f, f2 = ns > 2 ? fexp2(pm2 - M) : 0.f;
        const float rl = 1.f / fmaxf(st.l * f + (ns > 0 ? pl0 * f0 : 0.f) + (ns > 1 ? pl1 * f1 : 0.f) + (ns > 2 ? pl2 * f2 : 0.f), 1e-30f);
        const u16* zrow = (const u16*)(p.ws + WS_ZM) + row * 512 + hd * 64;
        u16* mrow = (u16*)(p.ws + WS_MIXED) + row * 1024 + hd * 64;
        uint2 r0[4], r1[4];
#pragma unroll
        for (int a = 0; a < 4; ++a) {
            const int d0 = 8 * a + 4 * h;
            const f32x4 zz = {0.f, 0.f, 0.f, 0.f};
            const f32x4 a0 = *(const f32x4*)(pp + 4 + d0), b0 = *(const f32x4*)(pp + 36 + d0);
            const f32x4 a1 = *(const f32x4*)(pp + 68 + 4 + d0), b1 = *(const f32x4*)(pp + 68 + 36 + d0);
            const f32x4 a2 = *(const f32x4*)(pp + 136 + 4 + d0), b2 = *(const f32x4*)(pp + 136 + 36 + d0);
            f32x4 v0 = {st.o0[4 * a] * f, st.o0[4 * a + 1] * f, st.o0[4 * a + 2] * f, st.o0[4 * a + 3] * f};
            f32x4 v1 = {st.o1[4 * a] * f, st.o1[4 * a + 1] * f, st.o1[4 * a + 2] * f, st.o1[4 * a + 3] * f};
            v0 += ns > 0 ? f0 * a0 : zz; v1 += ns > 0 ? f0 * b0 : zz;
            v0 += ns > 1 ? f1 * a1 : zz; v1 += ns > 1 ? f1 * b1 : zz;
            v0 += ns > 2 ? f2 * a2 : zz; v1 += ns > 2 ? f2 * b2 : zz;
            const uint2 z0 = *(const uint2*)(zrow + d0), z1 = *(const uint2*)(zrow + 32 + d0);
            r0[a] = cvt4(v0.x * rl * bf2f(z0.x & 0xffff), v0.y * rl * bf2f(z0.x >> 16), v0.z * rl * bf2f(z0.y & 0xffff), v0.w * rl * bf2f(z0.y >> 16));
            r1[a] = cvt4(v1.x * rl * bf2f(z1.x & 0xffff), v1.y * rl * bf2f(z1.x >> 16), v1.z * rl * bf2f(z1.y & 0xffff), v1.w * rl * bf2f(z1.y >> 16));
        }
#pragma unroll
        for (int a = 0; a < 4; ++a) { *(uint2*)(mrow + 8 * a + 4 * h) = r0[a]; *(uint2*)(mrow + 32 + 8 * a + 4 * h) = r1[a]; }
    }
    __syncthreads();
}

DI void nsa_item(const Params& p, char* sm, bool dec, int b, int kvh, int q32) {
    const int t = opaque(threadIdx.x), lane = t & 63, w = t >> 6, c = lane & 31, h = lane >> 5;
    const int g = c & 3;
    const int q0 = dec ? 8192 : q32 * 32, nq = dec ? 4 : 32;
    const int qi = 8 * w + (c >> 2), qic = qi < nq ? qi : nq - 1;
    const bool qvalid = qi < nq;
    const int qpos = q0 + qic;
    const size_t row = dec ? (size_t)NP + b * 4 + qic : (size_t)b * 8192 + qpos;
    const int head = kvh * 4 + g;
    const int cur = dec ? 128 : (q0 >> 6);
    int* list = (int*)(sm + SM_LIST);
    float* lutall = (float*)(sm + SM_LUT);
    const float* lut = lutall + g * LW;
    unsigned* misc = (unsigned*)(sm + SM_MISC);
    unsigned* selw = (unsigned*)(sm + SM_SEL);
    float* imp = (float*)(sm + SM_BIG);
    const int qmin_w = q0 + (8 * w < nq ? 8 * w : nq - 1), qmax_w = q0 + (8 * w + 7 < nq ? 8 * w + 7 : nq - 1);

    bf16x8 qf[4];
    {
        const u16* qrow = (const u16*)(p.ws + WS_QN) + row * 512 + head * 64;
#pragma unroll
        for (int ks = 0; ks < 4; ++ks) qf[ks] = *(const bf16x8*)(qrow + 16 * ks + 8 * h);
    }
    for (int i = t; i < 4 * LW; i += 256) lutall[i] = ((const float*)(p.ws + WS_LUTG))[(size_t)(8 + kvh * 4 + i / LW) * 2 * LW + (i % LW)];
    for (int i = t; i < 32 * IMPLD; i += 256) imp[i] = 0.f;
    const int ntok = dec ? 511 : (q0 / 16 + 1);
    if (t == 0) {
        int n = 0;
#pragma unroll 1
        for (int pos0 = 0; pos0 < ntok; pos0 += 64) list[n++] = pos0;
        list[159] = n;
        misc[0] = misc[1] = misc[2] = misc[3] = 0u;
    }
    __syncthreads();
    const float bfar = lut[128 + 127];
    const float* gt = (const float*)(p.ws + WS_GATES) + row * 24 + head * 3;
    const float g0 = gt[0], g1 = gt[1], g2 = gt[2];
    float* trow = (float*)(p.ws + WS_XNEW) + row * 512 + head * 64 + 4 * h;
    {
        const size_t cb = (size_t)((dec ? 2 + b : b) * 2 + kvh) * 512 * 64;
        const BSrc bs{(const u16*)(p.ws + WS_CKB) + cb, (const u16*)(p.ws + WS_CVB) + cb, 510};
        const int ntile = list[159];
        Flash st; flash_init(st);
        const OnFn onf{0, qvalid, 0ull, 0ull, 0};
        run_tiles_b<2, 1>(st, qf, bs, list, ntile, sm + SM_KV, qpos, qmin_w, qmax_w, onf, lut, 0.f, nullptr, 0.f);
        const float rinv = 1.f / fmaxf(st.l, 1e-30f);
        run_tiles_b<2, 2>(st, qf, bs, list, ntile, sm + SM_KV, qpos, qmin_w, qmax_w, onf, lut, 0.f, imp + qic * IMPLD, rinv);
        if (qvalid)
#pragma unroll
        for (int a = 0; a < 4; ++a) {
            f32x4 v0 = {g0 * st.o0[4 * a], g0 * st.o0[4 * a + 1], g0 * st.o0[4 * a + 2], g0 * st.o0[4 * a + 3]};
            f32x4 v1 = {g0 * st.o1[4 * a], g0 * st.o1[4 * a + 1], g0 * st.o1[4 * a + 2], g0 * st.o1[4 * a + 3]};
            *(f32x4*)(trow + 8 * a) = v0; *(f32x4*)(trow + 32 + 8 * a) = v1;
        }
    }
    {
        const int qc = t >> 3, part = t & 7, j0 = part * 16;
        unsigned bits = 0u;
        if (cur + 1 <= 16) {
#pragma unroll
            for (int jj = 0; jj < 16; ++jj) if (j0 + jj <= cur) bits |= 1u << jj;
        } else {
            const int K = 13;
            unsigned long long v[16]; int cnt[16];
#pragma unroll
            for (int jj = 0; jj < 16; ++jj) { v[jj] = ((unsigned long long)__float_as_uint(imp[qc * IMPLD + j0 + jj]) << 32) | (unsigned)(255 - (j0 + jj)); cnt[jj] = 0; }
            for (int k = 1; k <= cur - 2; ++k) {
                const unsigned long long x = ((unsigned long long)__float_as_uint(imp[qc * IMPLD + k]) << 32) | (unsigned)(255 - k);
#pragma unroll
                for (int jj = 0; jj < 16; ++jj) cnt[jj] += x > v[jj] ? 1 : 0;
            }
#pragma unroll
            for (int jj = 0; jj < 16; ++jj) {
                const int j = j0 + jj;
                const bool forced = (j == 0) || (j == cur) || (j == cur - 1);
                if (j <= cur && (forced || cnt[jj] < K)) bits |= 1u << jj;
            }
        }
        ((u16*)selw)[qc * 8 + part] = (u16)bits;
    }
    __syncthreads();
    unsigned s0 = selw[qic * 4 + 0], s1 = selw[qic * 4 + 1], s2 = selw[qic * 4 + 2], s3 = selw[qic * 4 + 3];
    if (!qvalid) { s0 = s1 = s2 = s3 = 0u; }
    {
        unsigned u0 = s0, u1 = s1, u2 = s2, u3 = s3;
#pragma unroll
        for (int o = 1; o < 64; o <<= 1) {
            u0 |= (unsigned)__shfl_xor((int)u0, o); u1 |= (unsigned)__shfl_xor((int)u1, o);
            u2 |= (unsigned)__shfl_xor((int)u2, o); u3 |= (unsigned)__shfl_xor((int)u3, o);
        }
        if (lane == 0) { atomicOr(&misc[0], u0); atomicOr(&misc[1], u1); atomicOr(&misc[2], u2); atomicOr(&misc[3], u3); }
    }
    __syncthreads();
    if (t < 128) {
        const unsigned u0 = misc[0], u1 = misc[1], u2 = misc[2], u3 = misc[3];
        const int wq = t >> 5;
        const unsigned wv = wq == 0 ? u0 : (wq == 1 ? u1 : (wq == 2 ? u2 : u3));
        const int before = (wq > 0 ? __popc(u0) : 0) + (wq > 1 ? __popc(u1) : 0) + (wq > 2 ? __popc(u2) : 0);
        if ((wv >> (t & 31)) & 1u) list[before + __popc(wv & ((1u << (t & 31)) - 1u))] = t * 64;
        if (t == 0) {
            int n = __popc(u0) + __popc(u1) + __popc(u2) + __popc(u3);
            if (cur == 128) list[n++] = 128 * 64;
            list[159] = n;
        }
    }
    __syncthreads();
    {
        const int ntile = list[159];
        Flash st; flash_init(st);
        const OnFn onf{2, qvalid, (unsigned long long)s0 | ((unsigned long long)s1 << 32), (unsigned long long)s2 | ((unsigned long long)s3 << 32), cur};
        if (dec) {
            TileSrc src;
            src.base = p.cache_n; src.pt = p.page_table; src.base_new = p.out + O_NKS;
            src.P = 8192; src.ld = 512; src.newbs = 4; src.kcol = 256 + kvh * 64; src.vcol = 384 + kvh * 64; src.b = b; src.posoff = 0;
            src.maxsrc = 8195;
            run_tiles<0, 0>(st, qf, src, list, ntile, sm + SM_KV, qpos, qmin_w, qmax_w, onf, lut, bfar, nullptr, 0.f);
        } else {
            const size_t hb = (size_t)(b * 2 + kvh) * 8192 * 64;
            const BSrc bs{(const u16*)(p.ws + WS_KSB) + hb, (const u16*)(p.ws + WS_VSB) + hb, 8191};
            run_tiles_b<0, 0>(st, qf, bs, list, ntile, sm + SM_KV, qpos, qmin_w, qmax_w, onf, lut, bfar, nullptr, 0.f);
        }
        const float rl = g1 / fmaxf(st.l, 1e-30f);
        if (qvalid)
#pragma unroll
        for (int a = 0; a < 4; ++a) {
            f32x4 v0 = *(const f32x4*)(trow + 8 * a), v1 = *(const f32x4*)(trow + 32 + 8 * a);
            v0.x += rl * st.o0[4 * a]; v0.y += rl * st.o0[4 * a + 1]; v0.z += rl * st.o0[4 * a + 2]; v0.w += rl * st.o0[4 * a + 3];
            v1.x += rl * st.o1[4 * a]; v1.y += rl * st.o1[4 * a + 1]; v1.z += rl * st.o1[4 * a + 2]; v1.w += rl * st.o1[4 * a + 3];
            *(f32x4*)(trow + 8 * a) = v0; *(f32x4*)(trow + 32 + 8 * a) = v1;
        }
    }
    {
        for (int i = t; i < 4 * LW; i += 256) lutall[i] = ((const float*)(p.ws + WS_LUTG))[(size_t)(8 + kvh * 4 + i / LW) * 2 * LW + LW + (i % LW)];
        if (t == 0) {
            int n = 0;
            int lo = q0 - 511; lo = lo < 0 ? 0 : lo; lo &= ~63;
#pragma unroll 1
            for (int pos0 = lo; pos0 <= q0 + nq - 1; pos0 += 64) list[n++] = pos0;
            list[159] = n;
        }
        __syncthreads();
        const int ntile = list[159];
        Flash st; flash_init(st);
        const OnFn onf{0, qvalid, 0ull, 0ull, 0};
        if (dec) {
            TileSrc src;
            src.base = p.win_state; src.pt = nullptr; src.base_new = p.out + O_WS + (size_t)508 * 256;
            src.P = 512; src.ld = 256; src.newbs = 512; src.posoff = 7680; src.maxsrc = 515;
            src.kcol = kvh * 64; src.vcol = 128 + kvh * 64; src.b = b;
            run_tiles<1, 0>(st, qf, src, list, ntile, sm + SM_KV, qpos, qmin_w, qmax_w, onf, lut, bfar, nullptr, 0.f);
        } else {
            const size_t hb = (size_t)(b * 2 + kvh) * 8192 * 64;
            const BSrc bs{(const u16*)(p.ws + WS_KWB) + hb, (const u16*)(p.ws + WS_VWB) + hb, 8191};
            run_tiles_b<1, 0>(st, qf, bs, list, ntile, sm + SM_KV, qpos, qmin_w, qmax_w, onf, lut, bfar, nullptr, 0.f);
        }
        const float rl = g2 / fmaxf(st.l, 1e-30f);
        if (qvalid) {
            const u16* zrow = (const u16*)(p.ws + WS_ZN) + row * 512 + head * 64;
            u16* mrow = (u16*)(p.ws + WS_MIXED) + row * 1024 + 512 + head * 64;
#pragma unroll
            for (int a = 0; a < 4; ++a) {
                const int d0 = 8 * a + 4 * h;
                const f32x4 v0 = *(const f32x4*)(trow + 8 * a), v1 = *(const f32x4*)(trow + 32 + 8 * a);
                const uint2 z0 = *(const uint2*)(zrow + d0), z1 = *(const uint2*)(zrow + 32 + d0);
                *(uint2*)(mrow + d0) = cvt4((v0.x + rl * st.o0[4 * a]) * bf2f(z0.x & 0xffff), (v0.y + rl * st.o0[4 * a + 1]) * bf2f(z0.x >> 16),
                                            (v0.z + rl * st.o0[4 * a + 2]) * bf2f(z0.y & 0xffff), (v0.w + rl * st.o0[4 * a + 3]) * bf2f(z0.y >> 16));
                *(uint2*)(mrow + 32 + d0) = cvt4((v1.x + rl * st.o1[4 * a]) * bf2f(z1.x & 0xffff), (v1.y + rl * st.o1[4 * a + 1]) * bf2f(z1.x >> 16),
                                                 (v1.z + rl * st.o1[4 * a + 2]) * bf2f(z1.y & 0xffff), (v1.w + rl * st.o1[4 * a + 3]) * bf2f(z1.y >> 16));
            }
        }
    }
    __syncthreads();
}

constexpr int P2_CMP = 512, P2_G1 = 129 * 31;
DI void phase2(const Params& p, char* sm, int mode = 0) {
    if (mode != 2)
        for (int it = blockIdx.x; it < P2_CMP; it += gridDim.x) compress_item(p, true, it >> 8, (it >> 3) & 31, it & 7, sm);
    if (mode != 1) {
        const int x = blockIdx.x & 7, ntn = x < 7 ? 4 : 3, nb = gridDim.x >> 3, j = blockIdx.x >> 3;
        const int lim = 128 * ntn, nown = j < lim ? (lim - j + nb - 1) / nb : 0;
        auto tile_at = [&](int idx, int& tm, int& tn) -> bool {
            if (idx < nown) { const int s2 = j + idx * nb; tm = s2 / ntn; tn = 4 * x + s2 % ntn; return true; }
            const int e = j + (idx - nown) * nb;
            tm = 128; tn = e;
            return x == 7 && e < 31;
        };
        GemmRegs<ALoadBf16> G; bool pre = false;
        int tm = 0, tn = 0;
        bool have = tile_at(0, tm, tn);
        for (int idx = 0; have; ++idx) {
            int tmn = 0, tnn = 0;
            const bool hn = tile_at(idx + 1, tmn, tnn);
            gemm1_tile(p, G, pre, tm, tn, hn, tmn, tnn, sm);
            pre = hn; have = hn; tm = tmn; tn = tnn;
        }
    }
}
DI void phase3b(const Params& p, char* sm) {
    for (int it = blockIdx.x; it < 1024; it += gridDim.x) moba_sel_item(p, sm, (it >> 3) & 1, it & 7, 63 - (it >> 4));
}
constexpr int P4_CMPP = 32, P4_NSAS = 64, P4_MOBAS = 256, P4_NSAP = 1024, P4_PRE = 192;
constexpr int SM_PFX = 63744;
constexpr size_t WS_FLAG = WS_CTR + 12288;
DI void phase4(const Params& p, char* sm, int cidx = 0) {
    unsigned* ctr = (unsigned*)(p.ws + WS_CTR) + cidx * 64;
    unsigned* flag = (unsigned*)(p.ws + WS_FLAG);
    int* slot = (int*)(sm + LDS_BYTES - 16);
    int* pfx = (int*)(sm + SM_PFX);
    const unsigned* mcnt = (const unsigned*)(p.ws + WS_MCNT);
    for (int it = blockIdx.x; it < P4_CMPP; it += gridDim.x) {
        compress_item(p, false, it >> 4, (it >> 3) & 1, it & 7, sm);
        asm volatile("s_waitcnt vmcnt(0)" ::: "memory");
        __syncthreads();
        if (threadIdx.x == 0) {
            __builtin_amdgcn_fence(__ATOMIC_RELEASE, "agent");
            asm volatile("s_waitcnt vmcnt(0)" ::: "memory");
            (void)xb_add(&flag[64 * ((it >> 3) & 1)], 1u);
        }
    }
    for (int i = threadIdx.x; i < 512; i += NTHREADS) pfx[i] = i < 496 ? (int)((mcnt[i + (i / 31) + 0] + 127u) >> 7) : 0;
    __syncthreads();
    if (threadIdx.x < 64) {
        const int l = threadIdx.x;
        int c[8], tot = 0;
#pragma unroll
        for (int j = 0; j < 8; ++j) { c[j] = pfx[8 * l + j]; tot += c[j]; }
        int inc = tot;
#pragma unroll
        for (int o = 1; o < 64; o <<= 1) { const int y = __shfl_up(inc, o); if (l >= o) inc += y; }
        int base = inc - tot;
#pragma unroll
        for (int j = 0; j < 8; ++j) { if (8 * l + j < 496) pfx[8 * l + j] = base; base += c[j]; }
        if (l == 63) pfx[496] = inc;
    }
    __syncthreads();
    const int G = pfx[496];
    const int pre = G < P4_PRE ? G : P4_PRE;
    const int Gr = G - pre;
    const int nint = Gr < P4_NSAP ? Gr : P4_NSAP;
    const int total = P4_NSAS + P4_MOBAS + P4_NSAP + G;
    int seen = 0;
    for (;;) {
        if (threadIdx.x == 0) *slot = (int)__hip_atomic_fetch_add(ctr, 1u, __ATOMIC_RELAXED, __HIP_MEMORY_SCOPE_AGENT);
        __syncthreads();
        const int it = *slot;
        __syncthreads();
        if (it >= total) break;
        int r = it;
        if (r < P4_NSAS) { nsa_item(p, sm, true, r >> 1, r & 1, 0); continue; }
        r -= P4_NSAS;
        if (r < P4_MOBAS) { moba_item(p, sm, true, r >> 3, r & 7, 0); continue; }
        r -= P4_MOBAS;
        int kn = -1, kg = -1;
        if (r < pre) kg = r;
        else {
            r -= pre;
            if (r < 2 * nint) { if (r & 1) kg = pre + (r >> 1); else kn = r >> 1; }
            else if (Gr > P4_NSAP) kg = pre + r - nint; else kn = r - nint;
        }
        if (kn >= 0) {
            const int b = (kn >> 1) & 1;
            if (!((seen >> b) & 1)) {
                if (threadIdx.x == 0) {
                    unsigned sp = 0u;
                    while (xb_ld(&flag[64 * b]) < 16u) { __builtin_amdgcn_s_sleep(2); if (++sp > XB_SPIN_CAP) break; }
                    __builtin_amdgcn_fence(__ATOMIC_ACQUIRE, "agent");
                    asm volatile("s_waitcnt vmcnt(0)" ::: "memory");
                }
                __syncthreads();
                seen |= 1 << b;
            }
            nsa_item(p, sm, false, b, kn & 1, 255 - (kn >> 2));
            continue;
        }
        int lo = 0, hi = 496;
        while (hi - lo > 1) { const int mid = (lo + hi) >> 1; if (pfx[mid] <= kg) lo = mid; else hi = mid; }
        const int bh = lo / 31, n = lo - bh * 31;
        moba_gather_item(p, sm, bh >> 3, bh & 7, n, kg - pfx[lo], (int)mcnt[bh * 32 + n]);
    }
}
DI void phase4c(const Params& p, char* sm, int cidx = 0) {
    unsigned* ctr = (unsigned*)(p.ws + WS_CTR) + 128 + cidx * 64;
    int* slot = (int*)(sm + LDS_BYTES - 16);
    for (;;) {
        if (threadIdx.x == 0) *slot = (int)__hip_atomic_fetch_add(ctr, 1u, __ATOMIC_RELAXED, __HIP_MEMORY_SCOPE_AGENT);
        __syncthreads();
        const int it = *slot;
        __syncthreads();
        if (it >= 1024 + 8) break;
        if (it < 8) { GemmRegs<ALoadBf16> G; gemm2_tile(p, G, false, opaque_s(128), it, false, 0, 0, sm); continue; }
        const int r = it - 8;
        moba_own_item(p, sm, (r >> 3) & 1, r & 7, 63 - (r >> 4));
    }
}
DI void phase5(const Params& p, char* sm) {
    const int x = blockIdx.x & 7, nb = gridDim.x >> 3;
    GemmRegs<ALoadBf16> G; bool pre = false;
    for (int s2 = blockIdx.x >> 3; s2 < 128; s2 += nb) {
        const int s2n = s2 + nb; const bool hn = s2n < 128;
        gemm2_tile(p, G, pre, s2, x, hn, s2n, x, sm);
        pre = hn;
    }
}
DI void phase6(const Params& p, char* sm) {
    const int tt_ = opaque(threadIdx.x), lane = tt_ & 63, w = tt_ >> 6;
    const float* xnew = (const float*)(p.ws + WS_XNEW);
    for (int row = blockIdx.x * 4 + w; row < NT; row += gridDim.x * 4) {
        const float* xr = xnew + (size_t)row * 1024;
        float* yr = row < NP ? p.out + O_YP + (size_t)row * 1024 : p.out + O_YS + (size_t)(row - NP) * 1024;
        f32x4 v[4]; float ss = 0.f;
#pragma unroll
        for (int j = 0; j < 4; ++j) { v[j] = *(const f32x4*)(xr + lane * 4 + 256 * j); ss += v[j].x * v[j].x + v[j].y * v[j].y + v[j].z * v[j].z + v[j].w * v[j].w; }
        ss = wave_sum(ss);
        const float inv = rsqrtf(ss * (1.f / 1024.f) + 1e-6f);
#pragma unroll
        for (int j = 0; j < 4; ++j) {
            const f32x4 g = *(const f32x4*)(p.final_gain + lane * 4 + 256 * j);
            f32x4 o; o.x = v[j].x * inv * g.x; o.y = v[j].y * inv * g.y; o.z = v[j].z * inv * g.z; o.w = v[j].w * inv * g.w;
            *(f32x4*)(yr + lane * 4 + 256 * j) = o;
        }
    }
}

template <int PH>
__global__ void __launch_bounds__(NTHREADS, 2) phase_kernel(Params p) {
    extern __shared__ __attribute__((aligned(16))) char sm[];
    if (PH == 0) phase0(p, sm);
    else if (PH == 1) phase1(p, sm);
    else if (PH == 2) phase2(p, sm);
    else if (PH == 4) phase4(p, sm);
    else if (PH == 5) phase5(p, sm);
    else phase6(p, sm);
}

__global__ void __launch_bounds__(NTHREADS, 2) mega_kernel(Params p) {
    extern __shared__ __attribute__((aligned(16))) char sm[];
    uint4* xbw = (uint4*)(sm + LDS_BYTES - 32);
    if (threadIdx.x == 0) *xbw = make_uint4(0u, 0u, 0u, 0u);
    __syncthreads();
    XcdBarrier bar = xcd_barrier_post((unsigned*)(p.ws + WS_BAR), (volatile LAS unsigned*)(LAS char*)(sm + LDS_BYTES - 32));
    phase0(p, sm); xcd_barrier(bar);
    if (REP == 0) { phase0(p, sm); xcd_barrier(bar); }
    if (REP >= 1000 && REP < 1016) { phase0(p, sm, REP - 1000); xcd_barrier(bar); }
    phase1(p, sm); xcd_barrier(bar);
    if (REP == 1) { phase1(p, sm); xcd_barrier(bar); }
    phase2(p, sm); xcd_barrier(bar);
    if (REP == 2) { phase2(p, sm); xcd_barrier(bar); }
    if (REP == 20) { phase2(p, sm, 1); xcd_barrier(bar); }
    if (REP == 21) { phase2(p, sm, 2); xcd_barrier(bar); }
    phase3b(p, sm); xcd_barrier(bar);
    phase4(p, sm); xcd_barrier(bar);
    if (REP == 4) { phase4(p, sm, 1); xcd_barrier(bar); }
    phase4c(p, sm); xcd_barrier(bar);
    if (REP == 7) { phase4c(p, sm, 1); xcd_barrier(bar); }
    phase5(p, sm); xcd_barrier(bar);
    if (REP == 5) { phase5(p, sm); xcd_barrier(bar); }
    phase6(p, sm);
    if (REP == 6) { xcd_barrier(bar); phase6(p, sm); }
}

extern "C" void kernel_launch(void* const* d_in, const int* in_sizes, int n_in, void* d_out, int out_size, void* d_ws, size_t ws_size,
                              hipStream_t stream) {
    static int grid = 0;
    if (grid == 0) {
        if (n_in != 20 || ws_size < WS_END) { fprintf(stderr, "kernel_launch: unexpected n_in %d / ws %zu\n", n_in, ws_size); grid = -1; return; }
        int dev = 0, cus = 0, per_cu = 0;
        hipGetDevice(&dev);
        hipDeviceGetAttribute(&cus, hipDeviceAttributeMultiprocessorCount, dev);
#if MEGA
        hipFuncSetAttribute((const void*)mega_kernel, hipFuncAttributeMaxDynamicSharedMemorySize, LDS_BYTES);
        hipOccupancyMaxActiveBlocksPerMultiprocessor(&per_cu, (const void*)mega_kernel, NTHREADS, LDS_BYTES);
#else
        per_cu = 2;
#endif
        if (per_cu < 1) { fprintf(stderr, "kernel_launch: occupancy query %d\n", per_cu); per_cu = 1; }
        grid = cus * (per_cu < 2 ? per_cu : 2);
    }
    if (grid < 0) return;
    Params p{};
    p.x_p = (const float*)d_in[0]; p.x_s = (const float*)d_in[1]; p.c_p = (const float*)d_in[2]; p.c_s = (const float*)d_in[3];
    p.cache_m = (const float*)d_in[4]; p.cache_n = (const float*)d_in[5]; p.win_state = (const float*)d_in[6];
    p.page_table = (const int*)d_in[7];
    p.w_ada = (const float*)d_in[8]; p.b_ada = (const float*)d_in[9]; p.norm_gain = (const float*)d_in[10]; p.w_in = (const float*)d_in[11];
    p.cmp_pe = (const float*)d_in[12]; p.k_w1 = (const float*)d_in[13]; p.k_w2 = (const float*)d_in[14]; p.v_w1 = (const float*)d_in[15];
    p.v_w2 = (const float*)d_in[16]; p.w_out = (const float*)d_in[17]; p.rel_bias = (const float*)d_in[18]; p.final_gain = (const float*)d_in[19];
    p.out = (float*)d_out; p.ws = (unsigned char*)d_ws;
    hipMemsetAsync(d_ws, 0, WS_ZERO_BYTES, stream);
#if MEGA
    hipLaunchKernelGGL(mega_kernel, dim3(grid), dim3(NTHREADS), LDS_BYTES, stream, p);
#else
    hipLaunchKernelGGL(phase_kernel<0>, dim3(grid), dim3(NTHREADS), LDS_BYTES, stream, p);
    hipLaunchKernelGGL(phase_kernel<1>, dim3(grid), dim3(NTHREADS), LDS_BYTES, stream, p);
    hipLaunchKernelGGL(phase_kernel<2>, dim3(grid), dim3(NTHREADS), LDS_BYTES, stream, p);
    hipLaunchKernelGGL(phase_kernel<3>, dim3(grid), dim3(NTHREADS), LDS_BYTES, stream, p);
    hipLaunchKernelGGL(phase_kernel<4>, dim3(grid), dim3(NTHREADS), LDS_BYTES, stream, p);
    hipLaunchKernelGGL(phase_kernel<5>, dim3(grid), dim3(NTHREADS), LDS_BYTES, stream, p);
    hipLaunchKernelGGL(phase_kernel<6>, dim3(grid), dim3(NTHREADS), LDS_BYTES, stream, p);
#endif
}
```

```cpp
#include <hip/hip_runtime.h>
#include <stdint.h>
#include <stdio.h>

#ifndef MEGA
#define MEGA 1
#endif
#ifndef REP
#define REP -1
#endif

#define DI __device__ __forceinline__
#define LAS __attribute__((address_space(3)))

typedef __attribute__((ext_vector_type(8))) short bf16x8;
typedef __attribute__((ext_vector_type(4))) short s16x4;
typedef __attribute__((ext_vector_type(16))) float f32x16;
typedef __attribute__((ext_vector_type(4))) float f32x4;
typedef __attribute__((ext_vector_type(8))) float f32x8;
typedef __attribute__((ext_vector_type(8))) __bf16 bf8v;
typedef __attribute__((ext_vector_type(4))) __bf16 bf4v;
typedef unsigned short u16;

constexpr int NP = 16384, NS = 128, NT = NP + NS;
constexpr int DINP = 3968;
constexpr float LOG2E = 1.4426950408889634f;
constexpr size_t O_YP = 0, O_YS = 16777216, O_MKP = 16908288, O_MKS = 33685504, O_NKP = 33816576,
                 O_NKS = 42205184, O_WP = 42270720, O_WS = 42532864;
constexpr size_t al256(size_t x) { return (x + 255) & ~(size_t)255; }
constexpr size_t WS_BAR = 0;
constexpr size_t WS_CTR = 16384;
constexpr size_t WS_ZERO_BYTES = 32768;
constexpr size_t WS_MOD = 32768;
constexpr size_t WS_WTIN = al256(WS_MOD + (size_t)34 * 3072 * 4);
constexpr size_t WS_WTOUT = al256(WS_WTIN + (size_t)DINP * 1024 * 2);
constexpr size_t WS_WC1K = al256(WS_WTOUT + (size_t)1024 * 1024 * 2);
constexpr size_t WS_WC1V = al256(WS_WC1K + (size_t)128 * 2048 * 2);
constexpr size_t WS_WC2K = al256(WS_WC1V + (size_t)128 * 2048 * 2);
constexpr size_t WS_WC2V = al256(WS_WC2K + (size_t)64 * 128 * 2);
constexpr size_t WS_KMP = al256(WS_WC2V + (size_t)64 * 128 * 2);
constexpr size_t WS_KMS = al256(WS_KMP + (size_t)2 * 32 * 4 * 512 * 4);
constexpr size_t WS_H = al256(WS_KMS + (size_t)32 * 32 * 512 * 4);
constexpr size_t WS_QM = al256(WS_H + (size_t)NT * 1024 * 2);
constexpr size_t WS_ZM = al256(WS_QM + (size_t)NT * 512 * 2);
constexpr size_t WS_QN = al256(WS_ZM + (size_t)NT * 512 * 2);
constexpr size_t WS_ZN = al256(WS_QN + (size_t)NT * 512 * 2);
constexpr size_t WS_GATES = al256(WS_ZN + (size_t)NT * 512 * 2);
constexpr size_t WS_KMB = al256(WS_GATES + (size_t)NT * 24 * 4);
constexpr size_t WS_VMB = al256(WS_KMB + (size_t)2 * 8 * 8192 * 64 * 2);
constexpr size_t WS_KSB = al256(WS_VMB + (size_t)2 * 8 * 8192 * 64 * 2);
constexpr size_t WS_VSB = al256(WS_KSB + (size_t)2 * 2 * 8192 * 64 * 2);
constexpr size_t WS_KWB = al256(WS_VSB + (size_t)2 * 2 * 8192 * 64 * 2);
constexpr size_t WS_VWB = al256(WS_KWB + (size_t)2 * 2 * 8192 * 64 * 2);
constexpr size_t WS_CKB = al256(WS_VWB + (size_t)2 * 2 * 8192 * 64 * 2);
constexpr size_t WS_CVB = al256(WS_CKB + (size_t)34 * 2 * 512 * 64 * 2);
constexpr size_t WS_MIXED = al256(WS_CVB + (size_t)34 * 2 * 512 * 64 * 2);
constexpr size_t WS_XNEW = al256(WS_MIXED + (size_t)NT * 1024 * 2);
constexpr size_t WS_SEL = al256(WS_XNEW + (size_t)NT * 1024 * 4);
constexpr size_t WS_LIST = al256(WS_SEL + (size_t)2 * 8 * 8192 * 4);
constexpr size_t WS_PART = al256(WS_LIST + (size_t)2 * 8 * 32 * 8192 * 2);
constexpr size_t WS_END0 = al256(WS_PART + (size_t)2 * 8 * 8192 * 3 * 68 * 4);
constexpr size_t WS_LUTG = WS_END0;
constexpr size_t WS_END = al256(WS_LUTG + (size_t)16 * 2 * 768 * 4);
constexpr size_t WS_MCNT = WS_CTR + 4096;

constexpr int LDS_BYTES = 66560;
constexpr int NTHREADS = 256;

struct Params {
    const float *x_p, *x_s, *c_p, *c_s, *cache_m, *cache_n, *win_state;
    const int* page_table;
    const float *w_ada, *b_ada, *norm_gain, *w_in, *cmp_pe, *k_w1, *k_w2, *v_w1, *v_w2, *w_out, *rel_bias, *final_gain;
    float* out;
    unsigned char* ws;
};

DI bf16x8 cvt8(f32x4 a, f32x4 b) {
    f32x8 v = {a.x, a.y, a.z, a.w, b.x, b.y, b.z, b.w};
    return __builtin_bit_cast(bf16x8, __builtin_convertvector(v, bf8v));
}
DI uint2 cvt4(float a, float b, float c, float d) {
    f32x4 v = {a, b, c, d};
    return __builtin_bit_cast(uint2, __builtin_convertvector(v, bf4v));
}
DI u16 cvt1(float a) { __bf16 h = (__bf16)a; return __builtin_bit_cast(u16, h); }
DI float bf2f(u16 u) { return __uint_as_float((unsigned)u << 16); }
DI float fexp2(float x) { return __builtin_amdgcn_exp2f(x); }
DI float silu_f(float z) { return z / (1.f + __expf(-z)); }
DI float sigmoid_f(float z) { return 1.f / (1.f + __expf(-z)); }
DI int crow(int i, int h) { return (i & 3) + 8 * (i >> 2) + 4 * h; }
DI f32x16 mfma32(bf16x8 a, bf16x8 b, f32x16 c) { return __builtin_amdgcn_mfma_f32_32x32x16_bf16(a, b, c, 0, 0, 0); }
DI float wave_sum(float v) {
#pragma unroll
    for (int o = 1; o < 64; o <<= 1) v += __shfl_xor(v, o);
    return v;
}
DI int opaque(int v) { asm volatile("" : "+v"(v)); return v; }
DI int opaque_s(int v) { asm volatile("" : "+s"(v)); return v; }
DI f32x16 zero16() { f32x16 z; for (int i = 0; i < 16; ++i) z[i] = 0.f; return z; }
DI s16x4 tr_read(const char* p) {
    return __builtin_amdgcn_ds_read_tr16_b64_v4i16((LAS s16x4*)(LAS char*)p);
}

#define XB_TMO      128
#define XB_XCNT(j)  (256  + 64 * (j))
#define XB_XSUB(j)  (1280 + 64 * (j))
#define XB_XGEN(j)  (2304 + 64 * (j))
#define XB_TOP      3328
#define XB_TOPGEN   3392
#define XCD_BAR_WORDS 3456
#define XB_SPIN_CAP (1u << 22)

DI unsigned xb_ld(unsigned* p)              { return __hip_atomic_load(p, __ATOMIC_RELAXED, __HIP_MEMORY_SCOPE_AGENT); }
DI unsigned xb_add(unsigned* p, unsigned v) { return __hip_atomic_fetch_add(p, v, __ATOMIC_RELAXED, __HIP_MEMORY_SCOPE_AGENT); }
DI unsigned xb_xcc_id() { return (unsigned)__builtin_amdgcn_s_getreg((3 << 11) | 20) & 0xFu; }
#define XB_SPIN(cond, bar) do { unsigned _sp = 0; while (cond) { __builtin_amdgcn_s_sleep(1); \
    if ((++_sp & 255u) == 0u) { if (xb_ld(&(bar)[XB_TMO])) break; if (_sp > XB_SPIN_CAP) { atomicAdd(&(bar)[XB_TMO], 1u); break; } } } } while (0)

struct XcdBarrier { unsigned* bar; unsigned x; volatile LAS unsigned* st; };

DI XcdBarrier xcd_barrier_post(unsigned* bar, volatile LAS unsigned* st) {
    XcdBarrier b; b.bar = bar; b.x = xb_xcc_id(); b.st = st;
    if (threadIdx.x == 0) (void)xb_add(&bar[XB_XCNT(b.x)], 1u);
    return b;
}
DI void xcd_barrier_complete(unsigned* bar, unsigned x, unsigned& nloc, unsigned& nx) {
    const unsigned G = gridDim.x * gridDim.y * gridDim.z;
    unsigned sum, cnt, mine, sp = 0u;
    for (;;) {
        sum = 0u; cnt = 0u; mine = 0u;
#pragma unroll
        for (unsigned j = 0; j < 16; ++j) { const unsigned c = xb_ld(&bar[XB_XCNT(j)]); sum += c; cnt += (c > 0u) ? 1u : 0u; mine = (j == x) ? c : mine; }
        if (sum == G) break;
        __builtin_amdgcn_s_sleep(1);
        if ((++sp & 255u) == 0u) { if (xb_ld(&bar[XB_TMO])) break; if (sp > XB_SPIN_CAP) { atomicAdd(&bar[XB_TMO], 1u); break; } }
    }
    nloc = mine > 0u ? mine : 1u; nx = cnt > 0u ? cnt : 1u;
}
DI void xcd_barrier(const XcdBarrier& b) {
    asm volatile("s_waitcnt vmcnt(0)" ::: "memory");
    __syncthreads();
    if (threadIdx.x == 0) {
        unsigned* bar = b.bar;
        __builtin_amdgcn_s_waitcnt(0);
        unsigned nloc = b.st[0], nx = b.st[1];
        if (nloc == 0u) { xcd_barrier_complete(bar, b.x, nloc, nx); b.st[0] = nloc; b.st[1] = nx; }
        const unsigned old = xb_add(&bar[XB_XSUB(b.x)], 1u);
        const unsigned gen = old / nloc;
        if (old + 1u == (gen + 1u) * nloc) {
            __builtin_amdgcn_fence(__ATOMIC_RELEASE, "agent");
            asm volatile("s_waitcnt vmcnt(0)" ::: "memory");
            const unsigned og = xb_add(&bar[XB_TOP], 1u);
            const unsigned tg = og / nx;
            if (og + 1u == (tg + 1u) * nx) xb_add(&bar[XB_TOPGEN], 1u);
            else XB_SPIN(xb_ld(&bar[XB_TOPGEN]) == tg, bar);
            __builtin_amdgcn_fence(__ATOMIC_ACQUIRE, "agent");
            xb_add(&bar[XB_XGEN(b.x)], 1u);
            asm volatile("s_waitcnt vmcnt(0)" ::: "memory");
        } else {
            XB_SPIN(xb_ld(&bar[XB_XGEN(b.x)]) == gen, bar);
            __builtin_amdgcn_fence(__ATOMIC_ACQUIRE, "agent");
            asm volatile("s_waitcnt vmcnt(0)" ::: "memory");
        }
    }
    __syncthreads();
}

DI int t5_bucket(int n) {
    if (n < 16) return n;
    int b = 16;
    b += n >= 19; b += n >= 21; b += n >= 24; b += n >= 27; b += n >= 31; b += n >= 35; b += n >= 40; b += n >= 46;
    b += n >= 52; b += n >= 59; b += n >= 67; b += n >= 77; b += n >= 87; b += n >= 99; b += n >= 113;
    return b;
}

constexpr int LW = 768;
DI int perm_in(int n) { return n < 3328 ? n : (n < 3352 ? 3840 + (n - 3328) : n - 24); }

DI void transpose_item(const float* __restrict__ W, int K, int N, u16* __restrict__ WT, int kt, int nt, bool perm, char* sm) {
    float* scr = (float*)sm;
    const int t = opaque(threadIdx.x);
    const int k0 = kt * 64, n0 = nt * 64;
#pragma unroll 4
    for (int i = 0; i < 16; ++i) {
        const int kk = (t >> 6) + 4 * i, n = n0 + (t & 63);
        scr[kk * 65 + (t & 63)] = (n < N) ? W[(size_t)(k0 + kk) * N + n] : 0.f;
    }
    __syncthreads();
    const int nl = t >> 2, kc = (t & 3) * 16, nn = n0 + nl;
    if (nn < N) {
        const int np = perm ? perm_in(nn) : nn;
        float v[16];
#pragma unroll
        for (int j = 0; j < 16; ++j) v[j] = scr[(kc + j) * 65 + nl];
        f32x4 a = {v[0], v[1], v[2], v[3]}, b = {v[4], v[5], v[6], v[7]}, c = {v[8], v[9], v[10], v[11]}, d = {v[12], v[13], v[14], v[15]};
        bf16x8* dst = (bf16x8*)(WT + (size_t)np * K + k0 + kc);
        dst[0] = cvt8(a, b); dst[1] = cvt8(c, d);
    }
    __syncthreads();
}

DI void kmean_item(const float* __restrict__ base, const int* __restrict__ pt, int b, int n, float* __restrict__ outp, char* sm) {
    float* scr = (float*)sm;
    const int t = opaque(threadIdx.x), lane = t & 63, w = t >> 6;
    f32x4 a0 = {0.f, 0.f, 0.f, 0.f}, a1 = {0.f, 0.f, 0.f, 0.f};
#pragma unroll
    for (int hf = 0; hf < 2; ++hf) {
        const int pos0 = n * 256 + hf * 128;
        const size_t r0 = pt ? (size_t)pt[b * 64 + (pos0 >> 7)] * 128 : (size_t)b * 8192 + pos0;
        const float* rp = base + (r0 + w) * 1024 + lane * 4;
#pragma unroll 4
        for (int rr = 0; rr < 32; ++rr) {
            a0 += __builtin_nontemporal_load((const f32x4*)(rp + (size_t)rr * 4096));
            a1 += __builtin_nontemporal_load((const f32x4*)(rp + (size_t)rr * 4096 + 256));
        }
    }
    *(f32x4*)(scr + w * 512 + lane * 4) = a0;
    *(f32x4*)(scr + w * 512 + 256 + lane * 4) = a1;
    __syncthreads();
#pragma unroll
    for (int j = 0; j < 2; ++j) {
        const int col = t + 256 * j;
        outp[col] = (scr[col] + scr[512 + col] + scr[1024 + col] + scr[1536 + col]) * (1.f / 256.f);
    }
    __syncthreads();
}

DI void ada_item(const Params& p, int item, char* sm) {
    float* scr = (float*)sm;
    float* mod = (float*)(p.ws + WS_MOD);
    const int t = opaque(threadIdx.x), cl = t & 15, kg = t >> 4, col0 = item * 16;
    float acc[36];
#pragma unroll
    for (int i = 0; i < 36; ++i) acc[i] = 0.f;
    for (int pass = 0; pass < 4; ++pass) {
#pragma unroll
        for (int bb = 0; bb < 34; ++bb) scr[t * 36 + bb] = bb < 2 ? p.c_p[bb * 1024 + pass * 256 + t] : p.c_s[(bb - 2) * 1024 + pass * 256 + t];
        if (pass == 0) { scr[t * 36 + 34] = 0.f; scr[t * 36 + 35] = 0.f; }
        __syncthreads();
        float wv[16];
#pragma unroll
        for (int kk = 0; kk < 16; ++kk) wv[kk] = p.w_ada[(size_t)(pass * 256 + kk * 16 + kg) * 3072 + col0 + cl];
#pragma unroll
        for (int kk = 0; kk < 16; ++kk) {
            const float* cr = scr + (kk * 16 + kg) * 36;
#pragma unroll
            for (int j = 0; j < 9; ++j) {
                const f32x4 c4 = *(const f32x4*)(cr + 4 * j);
                acc[4 * j] += c4.x * wv[kk]; acc[4 * j + 1] += c4.y * wv[kk]; acc[4 * j + 2] += c4.z * wv[kk]; acc[4 * j + 3] += c4.w * wv[kk];
            }
        }
        __syncthreads();
    }
#pragma unroll
    for (int bb = 0; bb < 34; ++bb) scr[(kg * 34 + bb) * 16 + cl] = acc[bb];
    __syncthreads();
    for (int o = t; o < 34 * 16; o += 256) {
        const int bb = o >> 4, c2 = o & 15;
        float s = p.b_ada[col0 + c2];
#pragma unroll
        for (int g = 0; g < 16; ++g) s += scr[(g * 34 + bb) * 16 + c2];
        mod[bb * 3072 + col0 + c2] = s;
    }
    __syncthreads();
}

constexpr int P0_KMS = 1024, P0_TWIN = 16 * 61, P0_TWOUT = 256, P0_W1 = 64, P0_W2 = 2, P0_ADA = 192, P0_WCP = 128, P0_PAD = 13, P0_LUT = 16;
constexpr int P0_ITEMS = P0_KMS + P0_TWIN + P0_TWOUT + 2 * P0_W1 + 2 * P0_W2 + P0_ADA + P0_WCP + P0_PAD + P0_LUT;

DI void phase0(const Params& p, char* sm, int msk = 15) {
    for (int it = blockIdx.x; it < P0_ITEMS; it += gridDim.x) {
        const int t = opaque(threadIdx.x);
        int r = it;
        if (r < P0_ADA) { if (msk & 1) ada_item(p, r, sm); continue; } r -= P0_ADA;
        if (r < P0_KMS) { if (msk & 2) kmean_item(p.cache_m, p.page_table, r >> 5, r & 31, (float*)(p.ws + WS_KMS) + (size_t)r * 512, sm); continue; } r -= P0_KMS;
        if (r < P0_TWIN + P0_TWOUT + 2 * P0_W1 + 2 * P0_W2) { if (!(msk & 4)) continue; } else if (!(msk & 8)) continue;
        if (r < P0_TWIN) { transpose_item(p.w_in, 1024, 3864, (u16*)(p.ws + WS_WTIN), r / 61, r % 61, true, sm); continue; } r -= P0_TWIN;
        if (r < P0_TWOUT) { transpose_item(p.w_out, 1024, 1024, (u16*)(p.ws + WS_WTOUT), r >> 4, r & 15, false, sm); continue; } r -= P0_TWOUT;
        if (r < P0_W1) { transpose_item(p.k_w1, 2048, 128, (u16*)(p.ws + WS_WC1K), r >> 1, r & 1, false, sm); continue; } r -= P0_W1;
        if (r < P0_W1) { transpose_item(p.v_w1, 2048, 128, (u16*)(p.ws + WS_WC1V), r >> 1, r & 1, false, sm); continue; } r -= P0_W1;
        if (r < P0_W2) { transpose_item(p.k_w2, 128, 64, (u16*)(p.ws + WS_WC2K), r, 0, false, sm); continue; } r -= P0_W2;
        if (r < P0_W2) { transpose_item(p.v_w2, 128, 64, (u16*)(p.ws + WS_WC2V), r, 0, false, sm); continue; } r -= P0_W2;
        if (r < P0_WCP) {
            const int b = r >> 2, q = r & 3;
            const f32x4* src = (const f32x4*)(p.win_state + ((size_t)b * 512 + 4) * 256) + q * 8128;
            f32x4* dst = (f32x4*)(p.out + O_WS + (size_t)b * 512 * 256) + q * 8128;
            for (int i0 = 0; i0 < 8128; i0 += 1024) {
                f32x4 v0, v1, v2, v3;
                const int ia = i0 + t, ib = ia + 256, ic = ia + 512, id = ia + 768;
                const int ja = ia < 8128 ? ia : 8127, jb = ib < 8128 ? ib : 8127, jc = ic < 8128 ? ic : 8127, jd = id < 8128 ? id : 8127;
                v0 = __builtin_nontemporal_load(src + ja); v1 = __builtin_nontemporal_load(src + jb);
                v2 = __builtin_nontemporal_load(src + jc); v3 = __builtin_nontemporal_load(src + jd);
                dst[ja] = v0; dst[jb] = v1; dst[jc] = v2; dst[jd] = v3;
            }
            continue;
        } r -= P0_WCP;
        if (r >= P0_PAD) {
            const int hd = r - P0_PAD;
            float* lg = (float*)(p.ws + WS_LUTG) + (size_t)hd * 2 * LW;
            for (int i = t; i < 2 * LW; i += 256) {
                const int var = i >= LW, rel = (var ? i - LW : i) - 128;
                const float bias = p.rel_bias[t5_bucket(rel < 0 ? 0 : (rel > 127 ? 127 : rel)) * 16 + hd] * LOG2E;
                lg[i] = (rel < 0 || (var && rel >= 512)) ? -1e30f : bias;
            }
            continue;
        }
        {
            uint4* dst = (uint4*)(p.ws + WS_WTIN + (size_t)3864 * 2048) + (size_t)r * 1024;
            const uint4 z = {0u, 0u, 0u, 0u};
            for (int i = t; i < 1024; i += 256) dst[i] = z;
        }
    }
}

DI void phase1(const Params& p, char* sm) {
    const int tt_ = opaque(threadIdx.x), lane = tt_ & 63, w = tt_ >> 6;
    const float* mod = (const float*)(p.ws + WS_MOD);
    u16* H = (u16*)(p.ws + WS_H);
    for (int row = blockIdx.x * 4 + w; row < NT; row += gridDim.x * 4) {
        const float* xr = row < NP ? p.x_p + (size_t)row * 1024 : p.x_s + (size_t)(row - NP) * 1024;
        const int mb = row < NP ? (row >> 13) : 2 + ((row - NP) >> 2);
        f32x4 v[4]; float ss = 0.f;
#pragma unroll
        for (int j = 0; j < 4; ++j) { v[j] = *(const f32x4*)(xr + lane * 4 + 256 * j); ss += v[j].x * v[j].x + v[j].y * v[j].y + v[j].z * v[j].z + v[j].w * v[j].w; }
        ss = wave_sum(ss);
        const float inv = rsqrtf(ss * (1.f / 1024.f) + 1e-6f);
#pragma unroll
        for (int j = 0; j < 4; ++j) {
            const int col = lane * 4 + 256 * j;
            const f32x4 g = *(const f32x4*)(p.norm_gain + col);
            const f32x4 sh = *(const f32x4*)(mod + mb * 3072 + col);
            const f32x4 sc = *(const f32x4*)(mod + mb * 3072 + 1024 + col);
            const float h0 = (v[j].x * inv) * g.x * (1.f + sc.x) + sh.x;
            const float h1 = (v[j].y * inv) * g.y * (1.f + sc.y) + sh.y;
            const float h2 = (v[j].z * inv) * g.z * (1.f + sc.z) + sh.z;
            const float h3 = (v[j].w * inv) * g.w * (1.f + sc.w) + sh.w;
            *(uint2*)(H + (size_t)row * 1024 + col) = cvt4(h0, h1, h2, h3);
        }
    }
}

struct TileSrc {
    const float* base; const int* pt; const float* base_new;
    int P, ld, newbs, kcol, vcol, b, posoff, maxsrc;
};
DI const float* ts_row(const TileSrc& s, int kpos) {
    int sp = kpos - s.posoff; sp = sp < 0 ? 0 : (sp > s.maxsrc ? s.maxsrc : sp);
    if (sp < s.P) {
        const size_t r = s.pt ? (size_t)s.pt[s.b * 64 + (sp >> 7)] * 128 + (sp & 127) : (size_t)s.b * s.P + sp;
        return s.base + r * s.ld;
    }
    return s.base_new + ((size_t)s.b * s.newbs + (sp - s.P)) * s.ld;
}

struct ALoadBf16 {
    const u16* A; int lda; int m0;
    struct Raw { bf16x8 v[4]; };
    static DI int kmap(int kt) { return kt; }
    DI void load(Raw& R, int kt) const {
        const int t = opaque(threadIdx.x), lrow = t >> 3, lch = t & 7;
#pragma unroll
        for (int i = 0; i < 4; ++i) R.v[i] = *(const bf16x8*)(A + (size_t)(m0 + lrow + 32 * i) * lda + kt * 64 + lch * 8);
    }
    DI void cvt(const Raw& R, bf16x8 (&o)[4], int) const {
#pragma unroll
        for (int i = 0; i < 4; ++i) o[i] = R.v[i];
    }
};
struct ALoadCmp {
    const float* base; const float* pe; int col; int pg0[2], pg1[2], pos0[2];
    struct Raw { f32x4 a[4], b[4]; };
    static DI int kmap(int kt) { return (kt >> 1) + 16 * (kt & 1); }
    DI void init(const float* base_, const int* pt, int b, int i0, int kv, const float* pe_) {
        base = base_; pe = pe_; col = kv * 128;
        const int lrow = opaque(threadIdx.x) >> 3;
#pragma unroll
        for (int j = 0; j < 2; ++j) {
            int blk = i0 + lrow + 32 * j; blk = blk > 510 ? 510 : blk;
            pos0[j] = 16 * blk;
            const int pg = pos0[j] >> 7, pgn = pg < 63 ? pg + 1 : 63;
            pg0[j] = pt ? pt[b * 64 + pg] : b * 64 + pg;
            pg1[j] = pt ? pt[b * 64 + pgn] : b * 64 + pgn;
        }
    }
    DI void load(Raw& R, int kt) const {
        const int lch = opaque(threadIdx.x) & 7;
#pragma unroll
        for (int j = 0; j < 2; ++j) {
            const int pos = pos0[j] + kt;
            const int pg = (pos >> 7) == (pos0[j] >> 7) ? pg0[j] : pg1[j];
            const float* rp = base + ((size_t)pg * 128 + (pos & 127)) * 512 + col + lch * 8;
            R.a[j] = *(const f32x4*)rp; R.b[j] = *(const f32x4*)(rp + 4);
            R.a[j + 2] = *(const f32x4*)(rp + 64); R.b[j + 2] = *(const f32x4*)(rp + 68);
        }
    }
    DI void cvt(const Raw& R, bf16x8 (&o)[4], int kt) const {
        const int lch = opaque(threadIdx.x) & 7;
        const f32x4 pe0 = *(const f32x4*)(pe + kt * 64 + lch * 8), pe1 = *(const f32x4*)(pe + kt * 64 + lch * 8 + 4);
#pragma unroll
        for (int i = 0; i < 4; ++i) o[i] = cvt8(R.a[i] + pe0, R.b[i] + pe1);
    }
};

template <class AL> struct GemmRegs { typename AL::Raw RA0, RA1; bf16x8 RB0[4], RB1[4]; };
template <class AL>
DI void gemm_mainloop(f32x16 (&acc)[2][2], GemmRegs<AL>& G, bool pre, const AL& al, const u16* __restrict__ Bt, int ldb, int n0, int nk, char* sm,
                      bool has_next, const AL& aln, int n0n) {
    const int t = opaque(threadIdx.x), lane = t & 63, w = t >> 6;
    const int wm = w >> 1, wn = w & 1, r = lane & 31, h = lane >> 5;
    const int lrow = t >> 3, lch = t & 7;
    typename AL::Raw& RA0 = G.RA0; typename AL::Raw& RA1 = G.RA1;
    bf16x8 (&RB0)[4] = G.RB0; bf16x8 (&RB1)[4] = G.RB1;
    const u16* bp = Bt + (size_t)(n0 + lrow) * ldb + lch * 8;
    const u16* bpn = Bt + (size_t)(n0n + lrow) * ldb + lch * 8;
    auto loadB = [&](bf16x8 (&rb)[4], int kt) {
#pragma unroll
        for (int i = 0; i < 4; ++i) rb[i] = *(const bf16x8*)(bp + (size_t)(32 * i) * ldb + kt * 64);
    };
    auto loadBn = [&](bf16x8 (&rb)[4], int kt) {
#pragma unroll
        for (int i = 0; i < 4; ++i) rb[i] = *(const bf16x8*)(bpn + (size_t)(32 * i) * ldb + kt * 64);
    };
    auto store = [&](const typename AL::Raw& RA, const bf16x8 (&rb)[4], int kt, char* dA) {
        bf16x8 ra[4];
        al.cvt(RA, ra, AL::kmap(kt));
#pragma unroll
        for (int i = 0; i < 4; ++i) {
            const int row = lrow + 32 * i;
            const int off = row * 128 + ((lch ^ ((row >> 1) & 7)) << 4);
            *(bf16x8*)(dA + off) = ra[i];
            *(bf16x8*)(dA + 16384 + off) = rb[i];
        }
    };
    auto compute = [&](const char* cA) {
        const char* cB = cA + 16384;
        bf16x8 a[2][2], b[2][2];
        auto rd = [&](int set, int ks) {
#pragma unroll
            for (int mi = 0; mi < 2; ++mi) { const int row = wm * 64 + mi * 32 + r; a[set][mi] = *(const bf16x8*)(cA + row * 128 + (((2 * ks + h) ^ ((row >> 1) & 7)) << 4)); }
#pragma unroll
            for (int ni = 0; ni < 2; ++ni) { const int row = wn * 64 + ni * 32 + r; b[set][ni] = *(const bf16x8*)(cB + row * 128 + (((2 * ks + h) ^ ((row >> 1) & 7)) << 4)); }
        };
        auto mm = [&](int set) {
#pragma unroll
            for (int mi = 0; mi < 2; ++mi)
#pragma unroll
                for (int ni = 0; ni < 2; ++ni) acc[mi][ni] = mfma32(a[set][mi], b[set][ni], acc[mi][ni]);
        };
        rd(0, 0); rd(1, 1);
        __builtin_amdgcn_sched_barrier(0);
        mm(0); rd(0, 2);
        __builtin_amdgcn_sched_barrier(0);
        mm(1); rd(1, 3);
        __builtin_amdgcn_sched_barrier(0);
        mm(0); mm(1);
    };
    char* buf0 = sm; char* buf1 = sm + 32768;
    if (!pre) {
        al.load(RA0, AL::kmap(0)); loadB(RB0, AL::kmap(0));
        al.load(RA1, AL::kmap(1)); loadB(RB1, AL::kmap(1));
    }
    store(RA0, RB0, 0, buf0);
    __syncthreads();
    if (2 < nk) { al.load(RA0, AL::kmap(2)); loadB(RB0, AL::kmap(2)); }
    for (int kt = 0; kt < nk; kt += 2) {
        compute(buf0);
        store(RA1, RB1, kt + 1, buf1);
        if (kt + 3 < nk) { al.load(RA1, AL::kmap(kt + 3)); loadB(RB1, AL::kmap(kt + 3)); }
        else if (has_next) { aln.load(RA1, AL::kmap(1)); loadBn(RB1, AL::kmap(1)); }
        __syncthreads();
        compute(buf1);
        if (kt + 2 < nk) {
            store(RA0, RB0, kt + 2, buf0);
            if (kt + 4 < nk) { al.load(RA0, AL::kmap(kt + 4)); loadB(RB0, AL::kmap(kt + 4)); }
            else if (has_next) { aln.load(RA0, AL::kmap(0)); loadBn(RB0, AL::kmap(0)); }
        }
        __syncthreads();
    }
}

template <int LD, int MODE>
DI void epi_store(const f32x16 (&acc)[2][2], float* fb, u16* bb) {
#pragma unroll
    for (int mi = 0; mi < 2; ++mi)
#pragma unroll
        for (int ni = 0; ni < 2; ++ni)
#pragma unroll
            for (int i = 0; i < 16; ++i) {
                const int off = (mi * 32 + (i & 3) + 8 * (i >> 2)) * LD + ni * 32;
                const float v = acc[mi][ni][i];
                if (MODE == 0) fb[off] = v;
                else if (MODE == 1) bb[off] = cvt1(v);
                else bb[off] = cvt1(silu_f(v));
            }
}

DI void gemm1_tile(const Params& p, GemmRegs<ALoadBf16>& G, bool pre, int tm, int tn, bool has_next, int tmn, int tnn, char* sm) {
    f32x16 acc[2][2];
#pragma unroll
    for (int a = 0; a < 2; ++a)
#pragma unroll
        for (int b = 0; b < 2; ++b) acc[a][b] = zero16();
    ALoadBf16 al{(const u16*)(p.ws + WS_H), 1024, tm * 128};
    ALoadBf16 aln{(const u16*)(p.ws + WS_H), 1024, tmn * 128};
    gemm_mainloop(acc, G, pre, al, (const u16*)(p.ws + WS_WTIN), 1024, tn * 128, 16, sm, has_next, aln, tnn * 128);
    const int t_ = opaque(threadIdx.x), lane = t_ & 63, w = t_ >> 6, wm = w >> 1, wn = w & 1, r = lane & 31, h = lane >> 5;
    const bool smp = tm == 128;
    const size_t rloc = (size_t)(smp ? 0 : tm * 128) + wm * 64 + 4 * h;
    const size_t rall = (size_t)tm * 128 + wm * 64 + 4 * h;
    const int cl = wn * 64 + r;
    if (tn < 4) epi_store<512, 1>(acc, nullptr, (u16*)(p.ws + WS_QM) + rall * 512 + tn * 128 + cl);
    else if (tn < 12) {
        epi_store<1024, 0>(acc, p.out + (smp ? O_MKS : O_MKP) + rloc * 1024 + (tn - 4) * 128 + cl, nullptr);
        if (!smp) {
            u16* dst = (u16*)(p.ws + (tn < 8 ? WS_KMB : WS_VMB)) + (((size_t)(tm >> 6) * 8 + 2 * (tn & 3) + wn) * 8192 + (tm & 63) * 128 + wm * 64 + 4 * h) * 64 + r;
            epi_store<64, 1>(acc, nullptr, dst);
            if (tn < 8) {
                float* kp = (float*)(p.ws + WS_KMP) + ((((size_t)(tm >> 6) * 32 + ((tm & 63) >> 1)) * 4 + (tm & 1) * 2 + wm) * 512) + (tn - 4) * 128 + cl;
#pragma unroll
                for (int ni = 0; ni < 2; ++ni) {
                    float cs = 0.f;
#pragma unroll
                    for (int mi = 0; mi < 2; ++mi)
#pragma unroll
                        for (int i = 0; i < 16; ++i) cs += acc[mi][ni][i];
                    cs += __shfl_xor(cs, 32);
                    if (h == 0) kp[ni * 32] = cs;
                }
            }
        }
    }
    else if (tn < 16) epi_store<512, 2>(acc, nullptr, (u16*)(p.ws + WS_ZM) + rall * 512 + (tn - 12) * 128 + cl);
    else if (tn < 20) epi_store<512, 1>(acc, nullptr, (u16*)(p.ws + WS_QN) + rall * 512 + (tn - 16) * 128 + cl);
    else if (tn < 24) {
        epi_store<512, 0>(acc, p.out + (smp ? O_NKS : O_NKP) + rloc * 512 + (tn - 20) * 128 + cl, nullptr);
        if (!smp && tn >= 22) {
            u16* dst = (u16*)(p.ws + (tn == 22 ? WS_KSB : WS_VSB)) + (((size_t)(tm >> 6) * 2 + wn) * 8192 + (tm & 63) * 128 + wm * 64 + 4 * h) * 64 + r;
            epi_store<64, 1>(acc, nullptr, dst);
        }
    }
    else if (tn < 26) {
        const int coff = (tn - 24) * 128 + cl;
        if (smp) {
            float* fb = p.out + O_WS + ((size_t)(wm * 16 + h) * 512 + 508) * 256 + coff;
#pragma unroll
            for (int mi = 0; mi < 2; ++mi)
#pragma unroll
                for (int ni = 0; ni < 2; ++ni)
#pragma unroll
                    for (int i = 0; i < 16; ++i) fb[((mi * 8 + 2 * (i >> 2)) * 512 + (i & 3)) * 256 + ni * 32] = acc[mi][ni][i];
        } else {
            u16* dst = (u16*)(p.ws + (tn == 24 ? WS_KWB : WS_VWB)) + (((size_t)(tm >> 6) * 2 + wn) * 8192 + (tm & 63) * 128 + wm * 64 + 4 * h) * 64 + r;
            epi_store<64, 1>(acc, nullptr, dst);
            if ((tm & 63) >= 60)
                epi_store<256, 0>(acc, p.out + O_WP + ((size_t)(tm >> 6) * 512 + ((tm & 63) - 60) * 128 + wm * 64 + 4 * h) * 256 + coff, nullptr);
        }
    }
    else if (tn < 30) epi_store<512, 2>(acc, nullptr, (u16*)(p.ws + WS_ZN) + rall * 512 + (tn - 26) * 128 + cl);
    else {
        if (wn == 0 && r < 24) {
            float* gb = (float*)(p.ws + WS_GATES) + rall * 24 + r;
#pragma unroll
            for (int mi = 0; mi < 2; ++mi)
#pragma unroll
                for (int i = 0; i < 16; ++i) gb[(mi * 32 + (i & 3) + 8 * (i >> 2)) * 24] = sigmoid_f(acc[mi][0][i]);
        }
    }
}

DI void gemm2_tile(const Params& p, GemmRegs<ALoadBf16>& G, bool pre, int tm, int tn, bool has_next, int tmn, int tnn, char* sm) {
    f32x16 acc[2][2];
#pragma unroll
    for (int a = 0; a < 2; ++a)
#pragma unroll
        for (int b = 0; b < 2; ++b) acc[a][b] = zero16();
    ALoadBf16 al{(const u16*)(p.ws + WS_MIXED), 1024, tm * 128};
    ALoadBf16 aln{(const u16*)(p.ws + WS_MIXED), 1024, tmn * 128};
    gemm_mainloop(acc, G, pre, al, (const u16*)(p.ws + WS_WTOUT), 1024, tn * 128, 16, sm, has_next, aln, tnn * 128);
    const int t_ = opaque(threadIdx.x), lane = t_ & 63, w = t_ >> 6, wm = w >> 1, wn = w & 1, r = lane & 31, h = lane >> 5;
    const bool smp = tm == 128;
    const float* mod = (const float*)(p.ws + WS_MOD);
    const int col = tn * 128 + wn * 64 + r;
    const size_t rloc = (size_t)(smp ? 0 : tm * 128) + wm * 64 + 4 * h;
    const float* xb = (smp ? p.x_s : p.x_p) + rloc * 1024 + col;
    float* ob = (float*)(p.ws + WS_XNEW) + ((size_t)tm * 128 + wm * 64 + 4 * h) * 1024 + col;
    const float* gb = mod + (size_t)(smp ? 2 + wm * 16 + h : (tm >> 6)) * 3072 + 2048 + col;
#pragma unroll
    for (int mi = 0; mi < 2; ++mi)
#pragma unroll
        for (int ni = 0; ni < 2; ++ni) {
            float xv[16], gv[16];
#pragma unroll
            for (int i = 0; i < 16; ++i) {
                const int off = (mi * 32 + (i & 3) + 8 * (i >> 2)) * 1024 + ni * 32;
                xv[i] = __builtin_nontemporal_load(xb + off);
                gv[i] = smp ? gb[(mi * 8 + 2 * (i >> 2)) * 3072 + ni * 32] : gb[ni * 32];
            }
#pragma unroll
            for (int i = 0; i < 16; ++i) {
                const int off = (mi * 32 + (i & 3) + 8 * (i >> 2)) * 1024 + ni * 32;
                ob[off] = xv[i] + gv[i] * acc[mi][ni][i];
            }
        }
}

DI void compress_item(const Params& p, bool dec, int kv, int b, int it8, char* sm) {
    f32x16 acc[2][2];
#pragma unroll
    for (int a = 0; a < 2; ++a)
#pragma unroll
        for (int c = 0; c < 2; ++c) acc[a][c] = zero16();
    ALoadCmp al;
    al.init(dec ? p.cache_n : p.out + O_NKP, dec ? p.page_table : nullptr, b, it8 * 64, kv, p.cmp_pe + kv * 2048);
    GemmRegs<ALoadCmp> G;
    gemm_mainloop(acc, G, false, al, (const u16*)(p.ws + (kv ? WS_WC1V : WS_WC1K)), 2048, 0, 32, sm, false, al, 0);
    const int t_ = opaque(threadIdx.x), lane = t_ & 63, w = t_ >> 6, wm = w >> 1, wn = w & 1, r = lane & 31, h = lane >> 5;
#pragma unroll
    for (int mi = 0; mi < 2; ++mi)
#pragma unroll
        for (int ni = 0; ni < 2; ++ni) {
            const int col = wn * 64 + ni * 32 + r;
#pragma unroll
            for (int i = 0; i < 16; ++i) {
                const int row = wm * 64 + mi * 32 + crow(i, h);
                *(u16*)(sm + row * 256 + ((((col >> 3) ^ (row & 15))) << 4) + (col & 7) * 2) = cvt1(silu_f(acc[mi][ni][i]));
            }
        }
    __syncthreads();
    f32x16 o2[2] = {zero16(), zero16()};
    const u16* w2t = (const u16*)(p.ws + (kv ? WS_WC2V : WS_WC2K));
    const int arow = 32 * w + r;
#pragma unroll
    for (int ks = 0; ks < 8; ++ks) {
        const bf16x8 a = *(const bf16x8*)(sm + arow * 256 + (((2 * ks + h) ^ (arow & 15)) << 4));
#pragma unroll
        for (int ni = 0; ni < 2; ++ni) {
            const bf16x8 bb = *(const bf16x8*)(w2t + (size_t)(ni * 32 + r) * 128 + 16 * ks + 8 * h);
            o2[ni] = mfma32(a, bb, o2[ni]);
        }
    }
    u16* cmp = (u16*)(p.ws + (kv ? WS_CVB : WS_CKB)) + ((size_t)((dec ? 2 + b : b) * 2 + (w >> 1)) * 512) * 64;
#pragma unroll
    for (int ni = 0; ni < 2; ++ni)
#pragma unroll
        for (int i = 0; i < 16; ++i) {
            const int blk = it8 * 64 + 32 * (w & 1) + crow(i, h);
            if (blk <= 510) cmp[(size_t)blk * 64 + ni * 32 + r] = cvt1(o2[ni][i]);
        }
    __syncthreads();
}

struct Flash { f32x16 o0, o1; float m, l; };
DI void flash_init(Flash& st) { st.o0 = zero16(); st.o1 = zero16(); st.m = -1e20f; st.l = 0.f; }

struct TileRegs { f32x4 k[4], v[4]; };
DI void tile_issue(TileRegs& R, const TileSrc& s, int pos0) {
    const int t = threadIdx.x;
    const float* rp = ts_row(s, pos0 + (t >> 2));
    const f32x4* kp = (const f32x4*)(rp + s.kcol + (t & 3) * 16);
    const f32x4* vp = (const f32x4*)(rp + s.vcol + (t & 3) * 16);
#pragma unroll
    for (int j = 0; j < 4; ++j) { R.k[j] = kp[j]; R.v[j] = vp[j]; }
}
DI void tile_store(const TileRegs& R, char* kbuf, char* vbuf) {
    const int t = threadIdx.x, key = t >> 2, q4 = t & 3, sw = (key >> 1) & 7;
    *(bf16x8*)(kbuf + key * 128 + (((2 * q4) ^ sw) << 4)) = cvt8(R.k[0], R.k[1]);
    *(bf16x8*)(kbuf + key * 128 + (((2 * q4 + 1) ^ sw) << 4)) = cvt8(R.k[2], R.k[3]);
    *(bf16x8*)(vbuf + key * 128 + (2 * q4) * 16) = cvt8(R.v[0], R.v[1]);
    *(bf16x8*)(vbuf + key * 128 + (2 * q4 + 1) * 16) = cvt8(R.v[2], R.v[3]);
}

constexpr int IMPLD = 132;

template <int MASK, bool NEAR, int PASS>
DI void flash_tile(Flash& st, const bf16x8 (&qf)[4], const char* kbuf, const char* vbuf, int pos0, int qpos, bool on,
                   const float* lut, float bfar, float* imp_row, float rinv) {
    const int lane = threadIdx.x & 63, r = lane & 31, h = lane >> 5;
    f32x16 s[2] = {zero16(), zero16()};
#pragma unroll
    for (int ks = 0; ks < 4; ++ks) {
        const int ka = r * 128 + (((2 * ks + h) ^ ((r >> 1) & 7)) << 4);
        const bf16x8 a0 = *(const bf16x8*)(kbuf + ka);
        const bf16x8 a1 = *(const bf16x8*)(kbuf + 4096 + ka);
        s[0] = mfma32(a0, qf[ks], s[0]);
        s[1] = mfma32(a1, qf[ks], s[1]);
    }
    constexpr float c1 = 0.125f * LOG2E;
    float alpha = 1.f;
    float rs = 0.f;
    if (!NEAR) {
        const float bc = MASK == 2 ? 0.f : bfar;
        float mref;
        if (PASS != 2) {
            float mr = s[0][0];
#pragma unroll
            for (int i = 1; i < 16; ++i) mr = fmaxf(mr, s[0][i]);
#pragma unroll
            for (int i = 0; i < 16; ++i) mr = fmaxf(mr, s[1][i]);
            float mx = on ? mr * c1 + bc : -1e30f;
            mx = fmaxf(mx, __shfl_xor(mx, 32));
            const float mnew = fmaxf(st.m, mx);
            alpha = fexp2(st.m - mnew);
            st.m = mnew;
            mref = mnew;
        } else mref = st.m;
        float bm = on ? bc - mref : -1e30f;
        if (PASS == 2) bm = on ? bm + __log2f(rinv) : -1e30f;
#pragma unroll
        for (int tt = 0; tt < 2; ++tt)
#pragma unroll
            for (int i = 0; i < 16; ++i) { const float pv = fexp2(s[tt][i] * c1 + bm); s[tt][i] = pv; rs += pv; }
    } else {
        float mx = -1e30f;
        if (MASK == 2) {
            const int dq = opaque(((qpos - 31) >> 4) - pos0 - 4 * h);
            const int oni = on ? 1 : 0;
#pragma unroll
            for (int tt = 0; tt < 2; ++tt)
#pragma unroll
                for (int i = 0; i < 16; ++i) {
                    const int rel = dq - (32 * tt + (i & 3) + 8 * (i >> 2));
                    float x = s[tt][i] * c1;
                    x = ((int)(rel >= 0) & oni) ? x : -1e30f;
                    s[tt][i] = x;
                    mx = fmaxf(mx, x);
                }
        } else {
            int dq = qpos - pos0 - 4 * h;
            dq = dq > 639 ? 639 : dq; dq = dq < -65 ? -65 : dq;
            dq = on ? dq : -65;
            const float* lp = lut + opaque(dq);
#pragma unroll
            for (int tt = 0; tt < 2; ++tt)
#pragma unroll
                for (int i = 0; i < 16; ++i) {
                    const float x = s[tt][i] * c1 + lp[128 - (32 * tt + (i & 3) + 8 * (i >> 2))];
                    s[tt][i] = x;
                    mx = fmaxf(mx, x);
                }
        }
        float mref;
        if (PASS != 2) {
            mx = fmaxf(mx, __shfl_xor(mx, 32));
            const float mnew = fmaxf(st.m, mx);
            alpha = fexp2(st.m - mnew);
            st.m = mnew;
            mref = mnew;
        } else mref = st.m;
#pragma unroll
        for (int tt = 0; tt < 2; ++tt)
#pragma unroll
            for (int i = 0; i < 16; ++i) {
                float pv = fexp2(s[tt][i] - mref);
                if (PASS == 2) pv *= rinv;
                s[tt][i] = pv; rs += pv;
            }
    }
    if (PASS != 2) {
        rs += __shfl_xor(rs, 32);
        st.l = st.l * alpha + rs;
    }
    f32x16 ia = zero16();
    if (PASS != 1) {
        if (PASS == 0) {
#pragma unroll
            for (int i = 0; i < 16; ++i) { st.o0[i] *= alpha; st.o1[i] *= alpha; }
        }
        const int G = lane >> 4, i16 = lane & 15, q = i16 >> 2, pp = i16 & 3;
        const char* vb = vbuf + (4 * (G >> 1) + q) * 128 + (16 * (G & 1) + 4 * pp) * 2;
#pragma unroll
        for (int tt = 0; tt < 2; ++tt)
#pragma unroll
            for (int ss = 0; ss < 2; ++ss) {
                f32x4 pa = {s[tt][8 * ss], s[tt][8 * ss + 1], s[tt][8 * ss + 2], s[tt][8 * ss + 3]};
                f32x4 pb2 = {s[tt][8 * ss + 4], s[tt][8 * ss + 5], s[tt][8 * ss + 6], s[tt][8 * ss + 7]};
                const bf16x8 pfrag = cvt8(pa, pb2);
                const char* vk = vb + (32 * tt + 16 * ss) * 128;
                if (PASS == 2) {
                    const int d = opaque((lane & 31) - h) - (8 * tt + 4 * ss);
                    const unsigned one2 = 0x3F803F80u, oneh = 0x3F800000u;
                    const uint4 ov = {d == 0 ? one2 : 0u, d == 0 ? one2 : (d == 1 ? oneh : 0u), d == 2 ? one2 : 0u, d == 2 ? one2 : (d == 3 ? oneh : 0u)};
                    ia = mfma32(__builtin_bit_cast(bf16x8, ov), pfrag, ia);
                }
                {
                    const s16x4 lo = tr_read(vk), hi = tr_read(vk + 8 * 128);
                    const bf16x8 va = __builtin_shufflevector(lo, hi, 0, 1, 2, 3, 4, 5, 6, 7);
                    st.o0 = mfma32(va, pfrag, st.o0);
                }
                {
                    const s16x4 lo = tr_read(vk + 64), hi = tr_read(vk + 8 * 128 + 64);
                    const bf16x8 va = __builtin_shufflevector(lo, hi, 0, 1, 2, 3, 4, 5, 6, 7);
                    st.o1 = mfma32(va, pfrag, st.o1);
                }
            }
    }
    if (PASS == 2) {
        float* dst = imp_row + (pos0 >> 2) + 4 * h;
        const bool wr = on && (lane & 3) == 0;
#pragma unroll
        for (int i = 0; i < 9; ++i) {
            float v = ia[i];
            v += __int_as_float(__builtin_amdgcn_update_dpp(0, __float_as_int(v), 0xB1, 0xf, 0xf, true));
            v += __int_as_float(__builtin_amdgcn_update_dpp(0, __float_as_int(v), 0x4E, 0xf, 0xf, true));
            if (wr && (i < 8 || h == 0)) dst[(i & 3) + 8 * (i >> 2)] += v;
        }
    }
}

struct OnFn {
    int kind; bool qvalid; unsigned long long lo, hi; int cur;
    DI bool operator()(int pos0) const {
        if (kind == 0) return qvalid;
        if (kind == 1) { const int blk = pos0 >> 8; return qvalid && (blk == cur || ((lo >> blk) & 1ull)); }
        const int j = pos0 >> 6;
        if (j >= 128) return qvalid;
        const unsigned long long x = j < 64 ? lo : hi;
        return qvalid && ((x >> (j & 63)) & 1ull) != 0ull;
    }
};

template <int MASK, int PASS>
DI void tile_step(Flash& st, const bf16x8 (&qf)[4], const char* kbuf, const char* vbuf, int pos0, int qpos, int qmin_w, int qmax_w,
                  const OnFn& onfn, const float* lut, float bfar, float* imp_row, float rinv) {
    const bool on = onfn(pos0);
    if (__any(on)) {
        bool farc;
        if (MASK == 0) farc = pos0 + 63 + 113 <= qmin_w;
        else if (MASK == 1) farc = (pos0 + 63 + 113 <= qmin_w) && (qmax_w - pos0 < 512);
        else farc = 16 * (pos0 + 63) + 31 <= qmin_w;
        if (farc) flash_tile<MASK, false, PASS>(st, qf, kbuf, vbuf, pos0, qpos, on, lut, bfar, imp_row, rinv);
        else flash_tile<MASK, true, PASS>(st, qf, kbuf, vbuf, pos0, qpos, on, lut, bfar, imp_row, rinv);
    }
}

template <int MASK, int PASS>
DI void run_tiles(Flash& st, const bf16x8 (&qf)[4], const TileSrc& src, const int* list, int n, char* kvbuf, int qpos,
                  int qmin_w, int qmax_w, const OnFn onfn, const float* lut, float bfar, float* imp_row, float rinv) {
    TileRegs R;
    if (n > 0) tile_issue(R, src, list[0]);
    for (int i = 0; i < n; ++i) {
        char* kbuf = kvbuf + (i & 1) * 16384; char* vbuf = kbuf + 8192;
        tile_store(R, kbuf, vbuf);
        __syncthreads();
        const int pos0 = list[i];
        if (i + 1 < n) tile_issue(R, src, list[i + 1]);
        tile_step<MASK, PASS>(st, qf, kbuf, vbuf, pos0, qpos, qmin_w, qmax_w, onfn, lut, bfar, imp_row, rinv);
    }
    __syncthreads();
}

struct BSrc { const u16* k; const u16* v; int maxpos; };
struct TileRegsB { bf16x8 k[2], v[2]; };
DI void tileb_issue(TileRegsB& R, const BSrc& s, int pos0) {
    const int t = threadIdx.x, c = t & 7;
    int r0 = pos0 + (t >> 3), r1 = r0 + 32;
    r0 = r0 < 0 ? 0 : (r0 > s.maxpos ? s.maxpos : r0);
    r1 = r1 < 0 ? 0 : (r1 > s.maxpos ? s.maxpos : r1);
    R.k[0] = *(const bf16x8*)(s.k + (size_t)r0 * 64 + c * 8); R.k[1] = *(const bf16x8*)(s.k + (size_t)r1 * 64 + c * 8);
    R.v[0] = *(const bf16x8*)(s.v + (size_t)r0 * 64 + c * 8); R.v[1] = *(const bf16x8*)(s.v + (size_t)r1 * 64 + c * 8);
}
DI void tileb_store(const TileRegsB& R, char* kbuf, char* vbuf) {
    const int t = threadIdx.x, key = t >> 3, c = t & 7, sw = (key >> 1) & 7;
    *(bf16x8*)(kbuf + key * 128 + ((c ^ sw) << 4)) = R.k[0];
    *(bf16x8*)(kbuf + 4096 + key * 128 + ((c ^ sw) << 4)) = R.k[1];
    *(bf16x8*)(vbuf + key * 128 + c * 16) = R.v[0];
    *(bf16x8*)(vbuf + 4096 + key * 128 + c * 16) = R.v[1];
}
template <int MASK, int PASS>
DI void run_tiles_b(Flash& st, const bf16x8 (&qf)[4], const BSrc& src, const int* list, int n, char* kvbuf, int qpos,
                    int qmin_w, int qmax_w, const OnFn onfn, const float* lut, float bfar, float* imp_row, float rinv) {
    TileRegsB RA, RB;
    if (n > 0) tileb_issue(RA, src, list[0]);
    if (n > 1) tileb_issue(RB, src, list[1]);
    for (int i = 0; i < n; i += 2) {
        {
            tileb_store(RA, kvbuf, kvbuf + 8192);
            __syncthreads();
            const int pos0 = list[i];
            if (i + 2 < n) tileb_issue(RA, src, list[i + 2]);
            tile_step<MASK, PASS>(st, qf, kvbuf, kvbuf + 8192, pos0, qpos, qmin_w, qmax_w, onfn, lut, bfar, imp_row, rinv);
        }
        if (i + 1 < n) {
            tileb_store(RB, kvbuf + 16384, kvbuf + 24576);
            __syncthreads();
            const int pos0 = list[i + 1];
            if (i + 3 < n) tileb_issue(RB, src, list[i + 3]);
            tile_step<MASK, PASS>(st, qf, kvbuf + 16384, kvbuf + 24576, pos0, qpos, qmin_w, qmax_w, onfn, lut, bfar, imp_row, rinv);
        }
    }
    __syncthreads();
}

constexpr int SM_KV = 0;
constexpr int SM_LIST = 32768;
constexpr int SM_LUT = 33792;
constexpr int SM_MISC = 46080;
constexpr int SM_SEL = 46336;
constexpr int SM_BIG = 46848;

DI void moba_item(const Params& p, char* sm, bool dec, int b, int hd, int qt) {
    const int t = opaque(threadIdx.x), lane = t & 63, w = t >> 6, c = lane & 31, h = lane >> 5;
    const int q0 = dec ? 8192 : qt * 128, nq = dec ? 4 : 128;
    const int qi = 32 * w + c, qic = qi < nq ? qi : nq - 1;
    const bool qvalid = qi < nq;
    const int qpos = q0 + qic;
    const size_t row = dec ? (size_t)NP + b * 4 + qic : (size_t)b * 8192 + qpos;
    const int cur = dec ? 32 : (q0 >> 8);
    int* list = (int*)(sm + SM_LIST);
    float* lut = (float*)(sm + SM_LUT);
    unsigned* misc = (unsigned*)(sm + SM_MISC);
    char* kmh = sm + SM_BIG; char* kml = sm + SM_BIG + 4096;

    bf16x8 qf[4];
    {
        const u16* qrow = (const u16*)(p.ws + WS_QM) + row * 512 + hd * 64;
#pragma unroll
        for (int ks = 0; ks < 4; ++ks) qf[ks] = *(const bf16x8*)(qrow + 16 * ks + 8 * h);
    }
    for (int i = t; i < LW; i += 256) lut[i] = ((const float*)(p.ws + WS_LUTG))[(size_t)hd * 2 * LW + i];
    {
        const int n = t >> 3, d0 = (t & 7) * 8;
        f32x4 a = {0.f, 0.f, 0.f, 0.f}, bq = a;
        if (n < cur) {
            const float* src = (const float*)(p.ws + WS_KMS) + ((size_t)b * 32 + n) * 512 + hd * 64 + d0;
            a = *(const f32x4*)src; bq = *(const f32x4*)(src + 4);
        }
        const bf16x8 hi = cvt8(a, bq);
        f32x4 ra, rb;
        ra.x = a.x - bf2f((u16)hi[0]); ra.y = a.y - bf2f((u16)hi[1]); ra.z = a.z - bf2f((u16)hi[2]); ra.w = a.w - bf2f((u16)hi[3]);
        rb.x = bq.x - bf2f((u16)hi[4]); rb.y = bq.y - bf2f((u16)hi[5]); rb.z = bq.z - bf2f((u16)hi[6]); rb.w = bq.w - bf2f((u16)hi[7]);
        *(bf16x8*)(kmh + n * 128 + d0 * 2) = hi;
        *(bf16x8*)(kml + n * 128 + d0 * 2) = cvt8(ra, rb);
    }
    if (t == 0) misc[0] = 0u;
    __syncthreads();
    f32x16 sc = zero16();
#pragma unroll
    for (int ks = 0; ks < 4; ++ks) {
        const bf16x8 ah = *(const bf16x8*)(kmh + c * 128 + (16 * ks + 8 * h) * 2);
        const bf16x8 al = *(const bf16x8*)(kml + c * 128 + (16 * ks + 8 * h) * 2);
        sc = mfma32(ah, qf[ks], sc);
        sc = mfma32(al, qf[ks], sc);
    }
    float v1 = -3e38f, v2 = -3e38f, v3 = -3e38f; int n1 = 99, n2 = 99, n3 = 99;
#pragma unroll
    for (int i = 0; i < 16; ++i) {
        const int n = crow(i, h);
        const float v = n < cur ? sc[i] : -3e38f;
        if (v > v1) { v3 = v2; n3 = n2; v2 = v1; n2 = n1; v1 = v; n1 = n; }
        else if (v > v2) { v3 = v2; n3 = n2; v2 = v; n2 = n; }
        else if (v > v3) { v3 = v; n3 = n; }
    }
    {
        const float pv[3] = {__shfl_xor(v1, 32), __shfl_xor(v2, 32), __shfl_xor(v3, 32)};
        const int pn[3] = {__shfl_xor(n1, 32), __shfl_xor(n2, 32), __shfl_xor(n3, 32)};
#pragma unroll
        for (int k = 0; k < 3; ++k) {
            const float v = pv[k]; const int n = pn[k];
            if (v > v1 || (v == v1 && n < n1)) { v3 = v2; n3 = n2; v2 = v1; n2 = n1; v1 = v; n1 = n; }
            else if (v > v2 || (v == v2 && n < n2)) { v3 = v2; n3 = n2; v2 = v; n2 = n; }
            else if (v > v3 || (v == v3 && n < n3)) { v3 = v; n3 = n; }
        }
    }
    unsigned sel = 0u;
    if (n1 < cur) sel |= 1u << n1;
    if (n2 < cur) sel |= 1u << n2;
    if (n3 < cur) sel |= 1u << n3;
    if (!qvalid) sel = 0u;
    {
        unsigned u = sel;
#pragma unroll
        for (int o = 1; o < 64; o <<= 1) u |= (unsigned)__shfl_xor((int)u, o);
        if (lane == 0) atomicOr(&misc[0], u);
    }
    __syncthreads();
    if (t == 0) {
        const unsigned U = misc[0];
        int n = 0;
        for (int blk = 0; blk <= cur; ++blk)
            if (blk == cur || ((U >> blk) & 1u))
                for (int sub = 0; sub < 4; ++sub) { const int pos0 = blk * 256 + sub * 64; if (pos0 <= q0 + nq - 1) list[n++] = pos0; }
        list[159] = n;
    }
    __syncthreads();
    const int ntile = list[159];
    TileSrc src;
    src.base = dec ? p.cache_m : p.out + O_MKP; src.pt = dec ? p.page_table : nullptr; src.base_new = p.out + O_MKS;
    src.P = 8192; src.ld = 1024; src.newbs = 4; src.kcol = hd * 64; src.vcol = 512 + hd * 64; src.b = b; src.posoff = 0;
    src.maxsrc = dec ? 8195 : 8191;
    Flash st; flash_init(st);
    const int qmin_w = q0 + (32 * w < nq ? 32 * w : nq - 1), qmax_w = q0 + (32 * w + 31 < nq ? 32 * w + 31 : nq - 1);
    const float bfar = lut[128 + 127];
    const OnFn onf{1, qvalid, (unsigned long long)sel, 0ull, cur};
    if (dec) run_tiles<0, 0>(st, qf, src, list, ntile, sm + SM_KV, qpos, qmin_w, qmax_w, onf, lut, bfar, nullptr, 0.f);
    else {
        BSrc bs{(const u16*)(p.ws + WS_KMB) + (size_t)(b * 8 + hd) * 8192 * 64, (const u16*)(p.ws + WS_VMB) + (size_t)(b * 8 + hd) * 8192 * 64, 8191};
        run_tiles_b<0, 0>(st, qf, bs, list, ntile, sm + SM_KV, qpos, qmin_w, qmax_w, onf, lut, bfar, nullptr, 0.f);
    }
    if (qvalid) {
        const float rl = 1.f / fmaxf(st.l, 1e-30f);
        const u16* zrow = (const u16*)(p.ws + WS_ZM) + row * 512 + hd * 64;
        u16* mrow = (u16*)(p.ws + WS_MIXED) + row * 1024 + hd * 64;
#pragma unroll
        for (int a = 0; a < 4; ++a) {
            const int d0 = 8 * a + 4 * h;
            const uint2 z0 = *(const uint2*)(zrow + d0), z1 = *(const uint2*)(zrow + 32 + d0);
            *(uint2*)(mrow + d0) = cvt4(st.o0[4 * a] * rl * bf2f(z0.x & 0xffff), st.o0[4 * a + 1] * rl * bf2f(z0.x >> 16),
                                        st.o0[4 * a + 2] * rl * bf2f(z0.y & 0xffff), st.o0[4 * a + 3] * rl * bf2f(z0.y >> 16));
            *(uint2*)(mrow + 32 + d0) = cvt4(st.o1[4 * a] * rl * bf2f(z1.x & 0xffff), st.o1[4 * a + 1] * rl * bf2f(z1.x >> 16),
                                             st.o1[4 * a + 2] * rl * bf2f(z1.y & 0xffff), st.o1[4 * a + 3] * rl * bf2f(z1.y >> 16));
        }
    }
    __syncthreads();
}

DI void moba_sel_item(const Params& p, char* sm, int b, int hd, int qt) {
    const int t = opaque(threadIdx.x), lane = t & 63, w = t >> 6, c = lane & 31, h = lane >> 5;
    const int q0 = qt * 128, q = q0 + 32 * w + c, cur = q0 >> 8;
    const size_t row = (size_t)b * 8192 + q;
    char* kmh = sm + SM_BIG; char* kml = sm + SM_BIG + 4096;
    unsigned* hist = (unsigned*)(sm + SM_MISC);
    unsigned* basep = (unsigned*)(sm + SM_MISC) + 32;
    unsigned* selg = (unsigned*)(p.ws + WS_SEL) + (size_t)(b * 8 + hd) * 8192;
    if (cur == 0) { if (h == 0) selg[q] = 0u; return; }
    bf16x8 qf[4];
    {
        const u16* qrow = (const u16*)(p.ws + WS_QM) + row * 512 + hd * 64;
#pragma unroll
        for (int ks = 0; ks < 4; ++ks) qf[ks] = *(const bf16x8*)(qrow + 16 * ks + 8 * h);
    }
    {
        const int n = t >> 3, d0 = (t & 7) * 8;
        f32x4 a = {0.f, 0.f, 0.f, 0.f}, bq = a;
        if (n < cur) {
            const float* src = (const float*)(p.ws + WS_KMP) + ((size_t)b * 32 + n) * 4 * 512 + hd * 64 + d0;
            a = (*(const f32x4*)src + *(const f32x4*)(src + 512)) + (*(const f32x4*)(src + 1024) + *(const f32x4*)(src + 1536));
            bq = (*(const f32x4*)(src + 4) + *(const f32x4*)(src + 516)) + (*(const f32x4*)(src + 1028) + *(const f32x4*)(src + 1540));
            a *= (1.f / 256.f); bq *= (1.f / 256.f);
        }
        const bf16x8 hi = cvt8(a, bq);
        f32x4 ra, rb;
        ra.x = a.x - bf2f((u16)hi[0]); ra.y = a.y - bf2f((u16)hi[1]); ra.z = a.z - bf2f((u16)hi[2]); ra.w = a.w - bf2f((u16)hi[3]);
        rb.x = bq.x - bf2f((u16)hi[4]); rb.y = bq.y - bf2f((u16)hi[5]); rb.z = bq.z - bf2f((u16)hi[6]); rb.w = bq.w - bf2f((u16)hi[7]);
        *(bf16x8*)(kmh + n * 128 + d0 * 2) = hi;
        *(bf16x8*)(kml + n * 128 + d0 * 2) = cvt8(ra, rb);
    }
    if (t < 32) hist[t] = 0u;
    __syncthreads();
    f32x16 sc = zero16();
#pragma unroll
    for (int ks = 0; ks < 4; ++ks) {
        const bf16x8 ah = *(const bf16x8*)(kmh + c * 128 + (16 * ks + 8 * h) * 2);
        const bf16x8 al = *(const bf16x8*)(kml + c * 128 + (16 * ks + 8 * h) * 2);
        sc = mfma32(ah, qf[ks], sc);
        sc = mfma32(al, qf[ks], sc);
    }
    float v1 = -3e38f, v2 = -3e38f, v3 = -3e38f; int n1 = 99, n2 = 99, n3 = 99;
#pragma unroll
    for (int i = 0; i < 16; ++i) {
        const int n = crow(i, h);
        const float v = n < cur ? sc[i] : -3e38f;
        if (v > v1) { v3 = v2; n3 = n2; v2 = v1; n2 = n1; v1 = v; n1 = n; }
        else if (v > v2) { v3 = v2; n3 = n2; v2 = v; n2 = n; }
        else if (v > v3) { v3 = v; n3 = n; }
    }
    {
        const float pv0 = __shfl_xor(v1, 32), pv1 = __shfl_xor(v2, 32), pv2 = __shfl_xor(v3, 32);
        const int pn0 = __shfl_xor(n1, 32), pn1 = __shfl_xor(n2, 32), pn2 = __shfl_xor(n3, 32);
#pragma unroll
        for (int k = 0; k < 3; ++k) {
            const float v = k == 0 ? pv0 : (k == 1 ? pv1 : pv2); const int n = k == 0 ? pn0 : (k == 1 ? pn1 : pn2);
            if (v > v1 || (v == v1 && n < n1)) { v3 = v2; n3 = n2; v2 = v1; n2 = n1; v1 = v; n1 = n; }
            else if (v > v2 || (v == v2 && n < n2)) { v3 = v2; n3 = n2; v2 = v; n2 = n; }
            else if (v > v3 || (v == v3 && n < n3)) { v3 = v; n3 = n; }
        }
    }
    unsigned sel = 0u;
    if (n1 < cur) sel |= 1u << n1;
    if (n2 < cur) sel |= 1u << n2;
    if (n3 < cur) sel |= 1u << n3;
    unsigned r1 = 0u, r2 = 0u, r3 = 0u;
    if (h == 0) {
        selg[q] = sel;
        if (n1 < cur) r1 = atomicAdd(&hist[n1], 1u);
        if (n2 < cur) r2 = atomicAdd(&hist[n2], 1u);
        if (n3 < cur) r3 = atomicAdd(&hist[n3], 1u);
    }
    __syncthreads();
    unsigned* mcnt = (unsigned*)(p.ws + WS_MCNT) + (b * 8 + hd) * 32;
    if (t < 32) basep[t] = hist[t] ? __hip_atomic_fetch_add(&mcnt[t], hist[t], __ATOMIC_RELAXED, __HIP_MEMORY_SCOPE_AGENT) : 0u;
    __syncthreads();
    if (h == 0) {
        u16* lst = (u16*)(p.ws + WS_LIST) + (size_t)(b * 8 + hd) * 32 * 8192;
        if (n1 < cur) lst[(size_t)n1 * 8192 + basep[n1] + r1] = (u16)q;
        if (n2 < cur) lst[(size_t)n2 * 8192 + basep[n2] + r2] = (u16)q;
        if (n3 < cur) lst[(size_t)n3 * 8192 + basep[n3] + r3] = (u16)q;
    }
    __syncthreads();
}

DI void moba_gather_item(const Params& p, char* sm, int b, int hd, int n, int chunk, int cnt) {
    const int t = opaque(threadIdx.x), lane = t & 63, w = t >> 6, c = lane & 31, h = lane >> 5;
    int* list = (int*)(sm + SM_LIST);
    float* lut = (float*)(sm + SM_LUT);
    const int e = chunk * 128 + 32 * w + c;
    const bool qvalid = e < cnt;
    const u16* lst = (const u16*)(p.ws + WS_LIST) + ((size_t)(b * 8 + hd) * 32 + n) * 8192;
    const int q = lst[qvalid ? e : cnt - 1];
    const size_t row = (size_t)b * 8192 + q;
    bf16x8 qf[4];
    {
        const u16* qrow = (const u16*)(p.ws + WS_QM) + row * 512 + hd * 64;
#pragma unroll
        for (int ks = 0; ks < 4; ++ks) qf[ks] = *(const bf16x8*)(qrow + 16 * ks + 8 * h);
    }
    for (int i = t; i < LW; i += 256) lut[i] = ((const float*)(p.ws + WS_LUTG))[(size_t)hd * 2 * LW + i];
    if (t < 4) list[t] = n * 256 + t * 64;
    __syncthreads();
    int qmin_w = qvalid ? q : 0x7fffffff;
#pragma unroll
    for (int o = 1; o < 64; o <<= 1) { const int x = __shfl_xor(qmin_w, o); qmin_w = x < qmin_w ? x : qmin_w; }
    const float bfar = lut[128 + 127];
    Flash st; flash_init(st);
    const OnFn onf{0, qvalid, 0ull, 0ull, 0};
    const BSrc bs{(const u16*)(p.ws + WS_KMB) + (size_t)(b * 8 + hd) * 8192 * 64, (const u16*)(p.ws + WS_VMB) + (size_t)(b * 8 + hd) * 8192 * 64, 8191};
    run_tiles_b<0, 0>(st, qf, bs, list, 4, sm + SM_KV, q, qmin_w, 0, onf, lut, bfar, nullptr, 0.f);
    if (qvalid) {
        const unsigned sel = ((const unsigned*)(p.ws + WS_SEL))[(size_t)(b * 8 + hd) * 8192 + q];
        const int slot = __popc(sel & ((1u << n) - 1u));
        float* pp = (float*)(p.ws + WS_PART) + (((size_t)(b * 8 + hd) * 8192 + q) * 3 + slot) * 68;
        if (h == 0) { pp[0] = st.m; pp[1] = st.l; }
#pragma unroll
        for (int a = 0; a < 4; ++a) {
            f32x4 v0 = {st.o0[4 * a], st.o0[4 * a + 1], st.o0[4 * a + 2], st.o0[4 * a + 3]};
            f32x4 v1 = {st.o1[4 * a], st.o1[4 * a + 1], st.o1[4 * a + 2], st.o1[4 * a + 3]};
            *(f32x4*)(pp + 4 + 8 * a + 4 * h) = v0; *(f32x4*)(pp + 4 + 32 + 8 * a + 4 * h) = v1;
        }
    }
    __syncthreads();
}

DI void moba_own_item(const Params& p, char* sm, int b, int hd, int qt) {
    const int t = opaque(threadIdx.x), lane = t & 63, w = t >> 6, c = lane & 31, h = lane >> 5;
    int* list = (int*)(sm + SM_LIST);
    float* lut = (float*)(sm + SM_LUT);
    const int q0 = qt * 128, q = q0 + 32 * w + c, cur = q0 >> 8;
    const size_t row = (size_t)b * 8192 + q;
    bf16x8 qf[4];
    {
        const u16* qrow = (const u16*)(p.ws + WS_QM) + row * 512 + hd * 64;
#pragma unroll
        for (int ks = 0; ks < 4; ++ks) qf[ks] = *(const bf16x8*)(qrow + 16 * ks + 8 * h);
    }
    for (int i = t; i < LW; i += 256) lut[i] = ((const float*)(p.ws + WS_LUTG))[(size_t)hd * 2 * LW + i];
    const int ntile = ((q0 + 127) >> 6) - cur * 4 + 1;
    if (t < 4) list[t] = cur * 256 + t * 64;
    __syncthreads();
    const float bfar = lut[128 + 127];
    Flash st; flash_init(st);
    const OnFn onf{0, true, 0ull, 0ull, 0};
    const BSrc bs{(const u16*)(p.ws + WS_KMB) + (size_t)(b * 8 + hd) * 8192 * 64, (const u16*)(p.ws + WS_VMB) + (size_t)(b * 8 + hd) * 8192 * 64, 8191};
    run_tiles_b<0, 0>(st, qf, bs, list, ntile, sm + SM_KV, q, q0 + 32 * w, 0, onf, lut, bfar, nullptr, 0.f);
    {
        const unsigned sel = ((const unsigned*)(p.ws + WS_SEL))[(size_t)(b * 8 + hd) * 8192 + q];
        const int ns = __popc(sel);
        const float* pp = (const float*)(p.ws + WS_PART) + ((size_t)(b * 8 + hd) * 8192 + q) * 3 * 68;
        const float pm0 = ns > 0 ? pp[0] : -1e20f, pm1 = ns > 1 ? pp[68] : -1e20f, pm2 = ns > 2 ? pp[136] : -1e20f;
        const float pl0 = pp[1], pl1 = pp[69], pl2 = pp[137];
        const float M = fmaxf(fmaxf(st.m, pm0), fmaxf(pm1, pm2));
        const float f = fexp2(st.m - M), f0 = ns > 0 ? fexp2(pm0 - M) : 0.f, f1 = ns > 1 ? fexp2(pm1 - M) : 0.f, f2 = ns > 2 ? fexp2(pm2 - M) : 0.f;
        const float rl = 1.f / fmaxf(st.l * f + (ns > 0 ? pl0 * f0 : 0.f) + (ns > 1 ? pl1 * f1 : 0.f) + (ns > 2 ? pl2 * f2 : 0.f), 1e-30f);
        const u16* zrow = (const u16*)(p.ws + WS_ZM) + row * 512 + hd * 64;
        u16* mrow = (u16*)(p.ws + WS_MIXED) + row * 1024 + hd * 64;
        uint2 r0[4], r1[4];
#pragma unroll
        for (int a = 0; a < 4; ++a) {
            const int d0 = 8 * a + 4 * h;
            const f32x4 zz = {0.f, 0.f, 0.f, 0.f};
            const f32x4 a0 = *(const f32x4*)(pp + 4 + d0), b0 = *(const f32x4*)(pp + 36 + d0);
            const f32x4 a1 = *(const f32x4*)(pp + 68 + 4 + d0), b1 = *(const f32x4*)(pp + 68 + 36 + d0);
            const f32x4 a2 = *(const f32x4*)(pp + 136 + 4 + d0), b2 = *(const f32x4*)(pp + 136 + 36 + d0);
            f32x4 v0 = {st.o0[4 * a] * f, st.o0[4 * a + 1] * f, st.o0[4 * a + 2] * f, st.o0[4 * a + 3] * f};
            f32x4 v1 = {st.o1[4 * a] * f, st.o1[4 * a + 1] * f, st.o1[4 * a + 2] * f, st.o1[4 * a + 3] * f};
            v0 += ns > 0 ? f0 * a0 : zz; v1 += ns > 0 ? f0 * b0 : zz;
            v0 += ns > 1 ? f1 * a1 : zz; v1 += ns > 1 ? f1 * b1 : zz;
            v0 += ns > 2 ? f2 * a2 : zz; v1 += ns > 2 ? f2 * b2 : zz;
            const uint2 z0 = *(const uint2*)(zrow + d0), z1 = *(const uint2*)(zrow + 32 + d0);
            r0[a] = cvt4(v0.x * rl * bf2f(z0.x & 0xffff), v0.y * rl * bf2f(z0.x >> 16), v0.z * rl * bf2f(z0.y & 0xffff), v0.w * rl * bf2f(z0.y >> 16));
            r1[a] = cvt4(v1.x * rl * bf2f(z1.x & 0xffff), v1.y * rl * bf2f(z1.x >> 16), v1.z * rl * bf2f(z1.y & 0xffff), v1.w * rl * bf2f(z1.y >> 16));
        }
#pragma unroll
        for (int a = 0; a < 4; ++a) { *(uint2*)(mrow + 8 * a + 4 * h) = r0[a]; *(uint2*)(mrow + 32 + 8 * a + 4 * h) = r1[a]; }
    }
    __syncthreads();
}

DI void nsa_item(const Params& p, char* sm, bool dec, int b, int kvh, int q32) {
    const int t = opaque(threadIdx.x), lane = t & 63, w = t >> 6, c = lane & 31, h = lane >> 5;
    const int g = c & 3;
    const int q0 = dec ? 8192 : q32 * 32, nq = dec ? 4 : 32;
    const int qi = 8 * w + (c >> 2), qic = qi < nq ? qi : nq - 1;
    const bool qvalid = qi < nq;
    const int qpos = q0 + qic;
    const size_t row = dec ? (size_t)NP + b * 4 + qic : (size_t)b * 8192 + qpos;
    const int head = kvh * 4 + g;
    const int cur = dec ? 128 : (q0 >> 6);
    int* list = (int*)(sm + SM_LIST);
    float* lutall = (float*)(sm + SM_LUT);
    const float* lut = lutall + g * LW;
    unsigned* misc = (unsigned*)(sm + SM_MISC);
    unsigned* selw = (unsigned*)(sm + SM_SEL);
    float* imp = (float*)(sm + SM_BIG);
    const int qmin_w = q0 + (8 * w < nq ? 8 * w : nq - 1), qmax_w = q0 + (8 * w + 7 < nq ? 8 * w + 7 : nq - 1);

    bf16x8 qf[4];
    {
        const u16* qrow = (const u16*)(p.ws + WS_QN) + row * 512 + head * 64;
#pragma unroll
        for (int ks = 0; ks < 4; ++ks) qf[ks] = *(const bf16x8*)(qrow + 16 * ks + 8 * h);
    }
    for (int i = t; i < 4 * LW; i += 256) lutall[i] = ((const float*)(p.ws + WS_LUTG))[(size_t)(8 + kvh * 4 + i / LW) * 2 * LW + (i % LW)];
    for (int i = t; i < 32 * IMPLD; i += 256) imp[i] = 0.f;
    const int ntok = dec ? 511 : (q0 / 16 + 1);
    if (t == 0) {
        int n = 0;
#pragma unroll 1
        for (int pos0 = 0; pos0 < ntok; pos0 += 64) list[n++] = pos0;
        list[159] = n;
        misc[0] = misc[1] = misc[2] = misc[3] = 0u;
    }
    __syncthreads();
    const float bfar = lut[128 + 127];
    const float* gt = (const float*)(p.ws + WS_GATES) + row * 24 + head * 3;
    const float g0 = gt[0], g1 = gt[1], g2 = gt[2];
    float* trow = (float*)(p.ws + WS_XNEW) + row * 512 + head * 64 + 4 * h;
    {
        const size_t cb = (size_t)((dec ? 2 + b : b) * 2 + kvh) * 512 * 64;
        const BSrc bs{(const u16*)(p.ws + WS_CKB) + cb, (const u16*)(p.ws + WS_CVB) + cb, 510};
        const int ntile = list[159];
        Flash st; flash_init(st);
        const OnFn onf{0, qvalid, 0ull, 0ull, 0};
        run_tiles_b<2, 1>(st, qf, bs, list, ntile, sm + SM_KV, qpos, qmin_w, qmax_w, onf, lut, 0.f, nullptr, 0.f);
        const float rinv = 1.f / fmaxf(st.l, 1e-30f);
        run_tiles_b<2, 2>(st, qf, bs, list, ntile, sm + SM_KV, qpos, qmin_w, qmax_w, onf, lut, 0.f, imp + qic * IMPLD, rinv);
        if (qvalid)
#pragma unroll
        for (int a = 0; a < 4; ++a) {
            f32x4 v0 = {g0 * st.o0[4 * a], g0 * st.o0[4 * a + 1], g0 * st.o0[4 * a + 2], g0 * st.o0[4 * a + 3]};
            f32x4 v1 = {g0 * st.o1[4 * a], g0 * st.o1[4 * a + 1], g0 * st.o1[4 * a + 2], g0 * st.o1[4 * a + 3]};
            *(f32x4*)(trow + 8 * a) = v0; *(f32x4*)(trow + 32 + 8 * a) = v1;
        }
    }
    {
        const int qc = t >> 3, part = t & 7, j0 = part * 16;
        unsigned bits = 0u;
        if (cur + 1 <= 16) {
#pragma unroll
            for (int jj = 0; jj < 16; ++jj) if (j0 + jj <= cur) bits |= 1u << jj;
        } else {
            const int K = 13;
            unsigned long long v[16]; int cnt[16];
#pragma unroll
            for (int jj = 0; jj < 16; ++jj) { v[jj] = ((unsigned long long)__float_as_uint(imp[qc * IMPLD + j0 + jj]) << 32) | (unsigned)(255 - (j0 + jj)); cnt[jj] = 0; }
            for (int k = 1; k <= cur - 2; ++k) {
                const unsigned long long x = ((unsigned long long)__float_as_uint(imp[qc * IMPLD + k]) << 32) | (unsigned)(255 - k);
#pragma unroll
                for (int jj = 0; jj < 16; ++jj) cnt[jj] += x > v[jj] ? 1 : 0;
            }
#pragma unroll
            for (int jj = 0; jj < 16; ++jj) {
                const int j = j0 + jj;
                const bool forced = (j == 0) || (j == cur) || (j == cur - 1);
                if (j <= cur && (forced || cnt[jj] < K)) bits |= 1u << jj;
            }
        }
        ((u16*)selw)[qc * 8 + part] = (u16)bits;
    }
    __syncthreads();
    unsigned s0 = selw[qic * 4 + 0], s1 = selw[qic * 4 + 1], s2 = selw[qic * 4 + 2], s3 = selw[qic * 4 + 3];
    if (!qvalid) { s0 = s1 = s2 = s3 = 0u; }
    {
        unsigned u0 = s0, u1 = s1, u2 = s2, u3 = s3;
#pragma unroll
        for (int o = 1; o < 64; o <<= 1) {
            u0 |= (unsigned)__shfl_xor((int)u0, o); u1 |= (unsigned)__shfl_xor((int)u1, o);
            u2 |= (unsigned)__shfl_xor((int)u2, o); u3 |= (unsigned)__shfl_xor((int)u3, o);
        }
        if (lane == 0) { atomicOr(&misc[0], u0); atomicOr(&misc[1], u1); atomicOr(&misc[2], u2); atomicOr(&misc[3], u3); }
    }
    __syncthreads();
    if (t < 128) {
        const unsigned u0 = misc[0], u1 = misc[1], u2 = misc[2], u3 = misc[3];
        const int wq = t >> 5;
        const unsigned wv = wq == 0 ? u0 : (wq == 1 ? u1 : (wq == 2 ? u2 : u3));
        const int before = (wq > 0 ? __popc(u0) : 0) + (wq > 1 ? __popc(u1) : 0) + (wq > 2 ? __popc(u2) : 0);
        if ((wv >> (t & 31)) & 1u) list[before + __popc(wv & ((1u << (t & 31)) - 1u))] = t * 64;
        if (t == 0) {
            int n = __popc(u0) + __popc(u1) + __popc(u2) + __popc(u3);
            if (cur == 128) list[n++] = 128 * 64;
            list[159] = n;
        }
    }
    __syncthreads();
    {
        const int ntile = list[159];
        Flash st; flash_init(st);
        const OnFn onf{2, qvalid, (unsigned long long)s0 | ((unsigned long long)s1 << 32), (unsigned long long)s2 | ((unsigned long long)s3 << 32), cur};
        if (dec) {
            TileSrc src;
            src.base = p.cache_n; src.pt = p.page_table; src.base_new = p.out + O_NKS;
            src.P = 8192; src.ld = 512; src.newbs = 4; src.kcol = 256 + kvh * 64; src.vcol = 384 + kvh * 64; src.b = b; src.posoff = 0;
            src.maxsrc = 8195;
            run_tiles<0, 0>(st, qf, src, list, ntile, sm + SM_KV, qpos, qmin_w, qmax_w, onf, lut, bfar, nullptr, 0.f);
        } else {
            const size_t hb = (size_t)(b * 2 + kvh) * 8192 * 64;
            const BSrc bs{(const u16*)(p.ws + WS_KSB) + hb, (const u16*)(p.ws + WS_VSB) + hb, 8191};
            run_tiles_b<0, 0>(st, qf, bs, list, ntile, sm + SM_KV, qpos, qmin_w, qmax_w, onf, lut, bfar, nullptr, 0.f);
        }
        const float rl = g1 / fmaxf(st.l, 1e-30f);
        if (qvalid)
#pragma unroll
        for (int a = 0; a < 4; ++a) {
            f32x4 v0 = *(const f32x4*)(trow + 8 * a), v1 = *(const f32x4*)(trow + 32 + 8 * a);
            v0.x += rl * st.o0[4 * a]; v0.y += rl * st.o0[4 * a + 1]; v0.z += rl * st.o0[4 * a + 2]; v0.w += rl * st.o0[4 * a + 3];
            v1.x += rl * st.o1[4 * a]; v1.y += rl * st.o1[4 * a + 1]; v1.z += rl * st.o1[4 * a + 2]; v1.w += rl * st.o1[4 * a + 3];
            *(f32x4*)(trow + 8 * a) = v0; *(f32x4*)(trow + 32 + 8 * a) = v1;
        }
    }
    {
        for (int i = t; i < 4 * LW; i += 256) lutall[i] = ((const float*)(p.ws + WS_LUTG))[(size_t)(8 + kvh * 4 + i / LW) * 2 * LW + LW + (i % LW)];
        if (t == 0) {
            int n = 0;
            int lo = q0 - 511; lo = lo < 0 ? 0 : lo; lo &= ~63;
#pragma unroll 1
            for (int pos0 = lo; pos0 <= q0 + nq - 1; pos0 += 64) list[n++] = pos0;
            list[159] = n;
        }
        __syncthreads();
        const int ntile = list[159];
        Flash st; flash_init(st);
        const OnFn onf{0, qvalid, 0ull, 0ull, 0};
        if (dec) {
            TileSrc src;
            src.base = p.win_state; src.pt = nullptr; src.base_new = p.out + O_WS + (size_t)508 * 256;
            src.P = 512; src.ld = 256; src.newbs = 512; src.posoff = 7680; src.maxsrc = 515;
            src.kcol = kvh * 64; src.vcol = 128 + kvh * 64; src.b = b;
            run_tiles<1, 0>(st, qf, src, list, ntile, sm + SM_KV, qpos, qmin_w, qmax_w, onf, lut, bfar, nullptr, 0.f);
        } else {
            const size_t hb = (size_t)(b * 2 + kvh) * 8192 * 64;
            const BSrc bs{(const u16*)(p.ws + WS_KWB) + hb, (const u16*)(p.ws + WS_VWB) + hb, 8191};
            run_tiles_b<1, 0>(st, qf, bs, list, ntile, sm + SM_KV, qpos, qmin_w, qmax_w, onf, lut, bfar, nullptr, 0.f);
        }
        const float rl = g2 / fmaxf(st.l, 1e-30f);
        if (qvalid) {
            const u16* zrow = (const u16*)(p.ws + WS_ZN) + row * 512 + head * 64;
            u16* mrow = (u16*)(p.ws + WS_MIXED) + row * 1024 + 512 + head * 64;
#pragma unroll
            for (int a = 0; a < 4; ++a) {
                const int d0 = 8 * a + 4 * h;
                const f32x4 v0 = *(const f32x4*)(trow + 8 * a), v1 = *(const f32x4*)(trow + 32 + 8 * a);
                const uint2 z0 = *(const uint2*)(zrow + d0), z1 = *(const uint2*)(zrow + 32 + d0);
                *(uint2*)(mrow + d0) = cvt4((v0.x + rl * st.o0[4 * a]) * bf2f(z0.x & 0xffff), (v0.y + rl * st.o0[4 * a + 1]) * bf2f(z0.x >> 16),
                                            (v0.z + rl * st.o0[4 * a + 2]) * bf2f(z0.y & 0xffff), (v0.w + rl * st.o0[4 * a + 3]) * bf2f(z0.y >> 16));
                *(uint2*)(mrow + 32 + d0) = cvt4((v1.x + rl * st.o1[4 * a]) * bf2f(z1.x & 0xffff), (v1.y + rl * st.o1[4 * a + 1]) * bf2f(z1.x >> 16),
                                                 (v1.z + rl * st.o1[4 * a + 2]) * bf2f(z1.y & 0xffff), (v1.w + rl * st.o1[4 * a + 3]) * bf2f(z1.y >> 16));
            }
        }
    }
    __syncthreads();
}

constexpr int P2_CMP = 512, P2_G1 = 129 * 31;
DI void phase2(const Params& p, char* sm, int mode = 0) {
    if (mode != 2)
        for (int it = blockIdx.x; it < P2_CMP; it += gridDim.x) compress_item(p, true, it >> 8, (it >> 3) & 31, it & 7, sm);
    if (mode != 1) {
        const int x = blockIdx.x & 7, ntn = x < 7 ? 4 : 3, nb = gridDim.x >> 3, j = blockIdx.x >> 3;
        const int lim = 128 * ntn, nown = j < lim ? (lim - j + nb - 1) / nb : 0;
        auto tile_at = [&](int idx, int& tm, int& tn) -> bool {
            if (idx < nown) { const int s2 = j + idx * nb; tm = s2 / ntn; tn = 4 * x + s2 % ntn; return true; }
            const int e = j + (idx - nown) * nb;
            tm = 128; tn = e;
            return x == 7 && e < 31;
        };
        GemmRegs<ALoadBf16> G; bool pre = false;
        int tm = 0, tn = 0;
        bool have = tile_at(0, tm, tn);
        for (int idx = 0; have; ++idx) {
            int tmn = 0, tnn = 0;
            const bool hn = tile_at(idx + 1, tmn, tnn);
            gemm1_tile(p, G, pre, tm, tn, hn, tmn, tnn, sm);
            pre = hn; have = hn; tm = tmn; tn = tnn;
        }
    }
}
DI void phase3b(const Params& p, char* sm) {
    for (int it = blockIdx.x; it < 1024; it += gridDim.x) moba_sel_item(p, sm, (it >> 3) & 1, it & 7, 63 - (it >> 4));
}
constexpr int P4_CMPP = 32, P4_NSAS = 64, P4_MOBAS = 256, P4_NSAP = 1024, P4_PRE = 192;
constexpr int SM_PFX = 63744;
constexpr size_t WS_FLAG = WS_CTR + 12288;
DI void phase4(const Params& p, char* sm, int cidx = 0) {
    unsigned* ctr = (unsigned*)(p.ws + WS_CTR) + cidx * 64;
    unsigned* flag = (unsigned*)(p.ws + WS_FLAG);
    int* slot = (int*)(sm + LDS_BYTES - 16);
    int* pfx = (int*)(sm + SM_PFX);
    const unsigned* mcnt = (const unsigned*)(p.ws + WS_MCNT);
    for (int it = blockIdx.x; it < P4_CMPP; it += gridDim.x) {
        compress_item(p, false, it >> 4, (it >> 3) & 1, it & 7, sm);
        asm volatile("s_waitcnt vmcnt(0)" ::: "memory");
        __syncthreads();
        if (threadIdx.x == 0) {
            __builtin_amdgcn_fence(__ATOMIC_RELEASE, "agent");
            asm volatile("s_waitcnt vmcnt(0)" ::: "memory");
            (void)xb_add(&flag[64 * ((it >> 3) & 1)], 1u);
        }
    }
    for (int i = threadIdx.x; i < 512; i += NTHREADS) pfx[i] = i < 496 ? (int)((mcnt[i + (i / 31) + 0] + 127u) >> 7) : 0;
    __syncthreads();
    if (threadIdx.x < 64) {
        const int l = threadIdx.x;
        int c[8], tot = 0;
#pragma unroll
        for (int j = 0; j < 8; ++j) { c[j] = pfx[8 * l + j]; tot += c[j]; }
        int inc = tot;
#pragma unroll
        for (int o = 1; o < 64; o <<= 1) { const int y = __shfl_up(inc, o); if (l >= o) inc += y; }
        int base = inc - tot;
#pragma unroll
        for (int j = 0; j < 8; ++j) { if (8 * l + j < 496) pfx[8 * l + j] = base; base += c[j]; }
        if (l == 63) pfx[496] = inc;
    }
    __syncthreads();
    const int G = pfx[496];
    const int pre = G < P4_PRE ? G : P4_PRE;
    const int Gr = G - pre;
    const int nint = Gr < P4_NSAP ? Gr : P4_NSAP;
    const int total = P4_NSAS + P4_MOBAS + P4_NSAP + G;
    int seen = 0;
    for (;;) {
        if (threadIdx.x == 0) *slot = (int)__hip_atomic_fetch_add(ctr, 1u, __ATOMIC_RELAXED, __HIP_MEMORY_SCOPE_AGENT);
        __syncthreads();
        const int it = *slot;
        __syncthreads();
        if (it >= total) break;
        int r = it;
        if (r < P4_NSAS) { nsa_item(p, sm, true, r >> 1, r & 1, 0); continue; }
        r -= P4_NSAS;
        if (r < P4_MOBAS) { moba_item(p, sm, true, r >> 3, r & 7, 0); continue; }
        r -= P4_MOBAS;
        int kn = -1, kg = -1;
        if (r < pre) kg = r;
        else {
            r -= pre;
            if (r < 2 * nint) { if (r & 1) kg = pre + (r >> 1); else kn = r >> 1; }
            else if (Gr > P4_NSAP) kg = pre + r - nint; else kn = r - nint;
        }
        if (kn >= 0) {
            const int b = (kn >> 1) & 1;
            if (!((seen >> b) & 1)) {
                if (threadIdx.x == 0) {
                    unsigned sp = 0u;
                    while (xb_ld(&flag[64 * b]) < 16u) { __builtin_amdgcn_s_sleep(2); if (++sp > XB_SPIN_CAP) break; }
                    __builtin_amdgcn_fence(__ATOMIC_ACQUIRE, "agent");
                    asm volatile("s_waitcnt vmcnt(0)" ::: "memory");
                }
                __syncthreads();
                seen |= 1 << b;
            }
            nsa_item(p, sm, false, b, kn & 1, 255 - (kn >> 2));
            continue;
        }
        int lo = 0, hi = 496;
        while (hi - lo > 1) { const int mid = (lo + hi) >> 1; if (pfx[mid] <= kg) lo = mid; else hi = mid; }
        const int bh = lo / 31, n = lo - bh * 31;
        moba_gather_item(p, sm, bh >> 3, bh & 7, n, kg - pfx[lo], (int)mcnt[bh * 32 + n]);
    }
}
DI void phase4c(const Params& p, char* sm, int cidx = 0) {
    unsigned* ctr = (unsigned*)(p.ws + WS_CTR) + 128 + cidx * 64;
    int* slot = (int*)(sm + LDS_BYTES - 16);
    for (;;) {
        if (threadIdx.x == 0) *slot = (int)__hip_atomic_fetch_add(ctr, 1u, __ATOMIC_RELAXED, __HIP_MEMORY_SCOPE_AGENT);
        __syncthreads();
        const int it = *slot;
        __syncthreads();
        if (it >= 1024 + 8) break;
        if (it < 8) { GemmRegs<ALoadBf16> G; gemm2_tile(p, G, false, opaque_s(128), it, false, 0, 0, sm); continue; }
        const int r = it - 8;
        moba_own_item(p, sm, (r >> 3) & 1, r & 7, 63 - (r >> 4));
    }
}
DI void phase5(const Params& p, char* sm) {
    const int x = blockIdx.x & 7, nb = gridDim.x >> 3;
    GemmRegs<ALoadBf16> G; bool pre = false;
    for (int s2 = blockIdx.x >> 3; s2 < 128; s2 += nb) {
        const int s2n = s2 + nb; const bool hn = s2n < 128;
        gemm2_tile(p, G, pre, s2, x, hn, s2n, x, sm);
        pre = hn;
    }
}
DI void phase6(const Params& p, char* sm) {
    const int tt_ = opaque(threadIdx.x), lane = tt_ & 63, w = tt_ >> 6;
    const float* xnew = (const float*)(p.ws + WS_XNEW);
    for (int row = blockIdx.x * 4 + w; row < NT; row += gridDim.x * 4) {
        const float* xr = xnew + (size_t)row * 1024;
        float* yr = row < NP ? p.out + O_YP + (size_t)row * 1024 : p.out + O_YS + (size_t)(row - NP) * 1024;
        f32x4 v[4]; float ss = 0.f;
#pragma unroll
        for (int j = 0; j < 4; ++j) { v[j] = *(const f32x4*)(xr + lane * 4 + 256 * j); ss += v[j].x * v[j].x + v[j].y * v[j].y + v[j].z * v[j].z + v[j].w * v[j].w; }
        ss = wave_sum(ss);
        const float inv = rsqrtf(ss * (1.f / 1024.f) + 1e-6f);
#pragma unroll
        for (int j = 0; j < 4; ++j) {
            const f32x4 g = *(const f32x4*)(p.final_gain + lane * 4 + 256 * j);
            f32x4 o; o.x = v[j].x * inv * g.x; o.y = v[j].y * inv * g.y; o.z = v[j].z * inv * g.z; o.w = v[j].w * inv * g.w;
            *(f32x4*)(yr + lane * 4 + 256 * j) = o;
        }
    }
}

template <int PH>
__global__ void __launch_bounds__(NTHREADS, 2) phase_kernel(Params p) {
    extern __shared__ __attribute__((aligned(16))) char sm[];
    if (PH == 0) phase0(p, sm);
    else if (PH == 1) phase1(p, sm);
    else if (PH == 2) phase2(p, sm);
    else if (PH == 4) phase4(p, sm);
    else if (PH == 5) phase5(p, sm);
    else phase6(p, sm);
}

__global__ void __launch_bounds__(NTHREADS, 2) mega_kernel(Params p) {
    extern __shared__ __attribute__((aligned(16))) char sm[];
    uint4* xbw = (uint4*)(sm + LDS_BYTES - 32);
    if (threadIdx.x == 0) *xbw = make_uint4(0u, 0u, 0u, 0u);
    __syncthreads();
    XcdBarrier bar = xcd_barrier_post((unsigned*)(p.ws + WS_BAR), (volatile LAS unsigned*)(LAS char*)(sm + LDS_BYTES - 32));
    phase0(p, sm); xcd_barrier(bar);
    if (REP == 0) { phase0(p, sm); xcd_barrier(bar); }
    if (REP >= 1000 && REP < 1016) { phase0(p, sm, REP - 1000); xcd_barrier(bar); }
    phase1(p, sm); xcd_barrier(bar);
    if (REP == 1) { phase1(p, sm); xcd_barrier(bar); }
    phase2(p, sm); xcd_barrier(bar);
    if (REP == 2) { phase2(p, sm); xcd_barrier(bar); }
    if (REP == 20) { phase2(p, sm, 1); xcd_barrier(bar); }
    if (REP == 21) { phase2(p, sm, 2); xcd_barrier(bar); }
    phase3b(p, sm); xcd_barrier(bar);
    phase4(p, sm); xcd_barrier(bar);
    if (REP == 4) { phase4(p, sm, 1); xcd_barrier(bar); }
    phase4c(p, sm); xcd_barrier(bar);
    if (REP == 7) { phase4c(p, sm, 1); xcd_barrier(bar); }
    phase5(p, sm); xcd_barrier(bar);
    if (REP == 5) { phase5(p, sm); xcd_barrier(bar); }
    phase6(p, sm);
    if (REP == 6) { xcd_barrier(bar); phase6(p, sm); }
}

extern "C" void kernel_launch(void* const* d_in, const int* in_sizes, int n_in, void* d_out, int out_size, void* d_ws, size_t ws_size,
                              hipStream_t stream) {
    static int grid = 0;
    if (grid == 0) {
        if (n_in != 20 || ws_size < WS_END) { fprintf(stderr, "kernel_launch: unexpected n_in %d / ws %zu\n", n_in, ws_size); grid = -1; return; }
        int dev = 0, cus = 0, per_cu = 0;
        hipGetDevice(&dev);
        hipDeviceGetAttribute(&cus, hipDeviceAttributeMultiprocessorCount, dev);
#if MEGA
        hipFuncSetAttribute((const void*)mega_kernel, hipFuncAttributeMaxDynamicSharedMemorySize, LDS_BYTES);
        hipOccupancyMaxActiveBlocksPerMultiprocessor(&per_cu, (const void*)mega_kernel, NTHREADS, LDS_BYTES);
#else
        per_cu = 2;
#endif
        if (per_cu < 1) { fprintf(stderr, "kernel_launch: occupancy query %d\n", per_cu); per_cu = 1; }
        grid = cus * (per_cu < 2 ? per_cu : 2);
    }
    if (grid < 0) return;
    Params p{};
    p.x_p = (const float*)d_in[0]; p.x_s = (const float*)d_in[1]; p.c_p = (const float*)d_in[2]; p.c_s = (const float*)d_in[3];
    p.cache_m = (const float*)d_in[4]; p.cache_n = (const float*)d_in[5]; p.win_state = (const float*)d_in[6];
    p.page_table = (const int*)d_in[7];
    p.w_ada = (const float*)d_in[8]; p.b_ada = (const float*)d_in[9]; p.norm_gain = (const float*)d_in[10]; p.w_in = (const float*)d_in[11];
    p.cmp_pe = (const float*)d_in[12]; p.k_w1 = (const float*)d_in[13]; p.k_w2 = (const float*)d_in[14]; p.v_w1 = (const float*)d_in[15];
    p.v_w2 = (const float*)d_in[16]; p.w_out = (const float*)d_in[17]; p.rel_bias = (const float*)d_in[18]; p.final_gain = (const float*)d_in[19];
    p.out = (float*)d_out; p.ws = (unsigned char*)d_ws;
    hipMemsetAsync(d_ws, 0, WS_ZERO_BYTES, stream);
#if MEGA
    hipLaunchKernelGGL(mega_kernel, dim3(grid), dim3(NTHREADS), LDS_BYTES, stream, p);
#else
    hipLaunchKernelGGL(phase_kernel<0>, dim3(grid), dim3(NTHREADS), LDS_BYTES, stream, p);
    hipLaunchKernelGGL(phase_kernel<1>, dim3(grid), dim3(NTHREADS), LDS_BYTES, stream, p);
    hipLaunchKernelGGL(phase_kernel<2>, dim3(grid), dim3(NTHREADS), LDS_BYTES, stream, p);
    hipLaunchKernelGGL(phase_kernel<3>, dim3(grid), dim3(NTHREADS), LDS_BYTES, stream, p);
    hipLaunchKernelGGL(phase_kernel<4>, dim3(grid), dim3(NTHREADS), LDS_BYTES, stream, p);
    hipLaunchKernelGGL(phase_kernel<5>, dim3(grid), dim3(NTHREADS), LDS_BYTES, stream, p);
    hipLaunchKernelGGL(phase_kernel<6>, dim3(grid), dim3(NTHREADS), LDS_BYTES, stream, p);
#endif
}
```

```cpp
#include <hip/hip_runtime.h>
#include <stdint.h>
#include <stdio.h>

#ifndef MEGA
#define MEGA 1
#endif
#ifndef REP
#define REP -1
#endif

#define DI __device__ __forceinline__
#define LAS __attribute__((address_space(3)))

typedef __attribute__((ext_vector_type(8))) short bf16x8;
typedef __attribute__((ext_vector_type(4))) short s16x4;
typedef __attribute__((ext_vector_type(16))) float f32x16;
typedef __attribute__((ext_vector_type(4))) float f32x4;
typedef __attribute__((ext_vector_type(8))) float f32x8;
typedef __attribute__((ext_vector_type(8))) __bf16 bf8v;
typedef __attribute__((ext_vector_type(4))) __bf16 bf4v;
typedef unsigned short u16;

constexpr int NP = 16384, NS = 128, NT = NP + NS;
constexpr int DINP = 3968;
constexpr float LOG2E = 1.4426950408889634f;
constexpr size_t O_YP = 0, O_YS = 16777216, O_MKP = 16908288, O_MKS = 33685504, O_NKP = 33816576,
                 O_NKS = 42205184, O_WP = 42270720, O_WS = 42532864;
constexpr size_t al256(size_t x) { return (x + 255) & ~(size_t)255; }
constexpr size_t WS_BAR = 0;
constexpr size_t WS_CTR = 16384;
constexpr size_t WS_ZERO_BYTES = 32768;
constexpr size_t WS_MOD = 32768;
constexpr size_t WS_WTIN = al256(WS_MOD + (size_t)34 * 3072 * 4);
constexpr size_t WS_WTOUT = al256(WS_WTIN + (size_t)DINP * 1024 * 2);
constexpr size_t WS_WC1K = al256(WS_WTOUT + (size_t)1024 * 1024 * 2);
constexpr size_t WS_WC1V = al256(WS_WC1K + (size_t)128 * 2048 * 2);
constexpr size_t WS_WC2K = al256(WS_WC1V + (size_t)128 * 2048 * 2);
constexpr size_t WS_WC2V = al256(WS_WC2K + (size_t)64 * 128 * 2);
constexpr size_t WS_KMP = al256(WS_WC2V + (size_t)64 * 128 * 2);
constexpr size_t WS_KMS = al256(WS_KMP + (size_t)2 * 32 * 4 * 512 * 4);
constexpr size_t WS_H = al256(WS_KMS + (size_t)32 * 32 * 512 * 4);
constexpr size_t WS_QM = al256(WS_H + (size_t)NT * 1024 * 2);
constexpr size_t WS_ZM = al256(WS_QM + (size_t)NT * 512 * 2);
constexpr size_t WS_QN = al256(WS_ZM + (size_t)NT * 512 * 2);
constexpr size_t WS_ZN = al256(WS_QN + (size_t)NT * 512 * 2);
constexpr size_t WS_GATES = al256(WS_ZN + (size_t)NT * 512 * 2);
constexpr size_t WS_KMB = al256(WS_GATES + (size_t)NT * 24 * 4);
constexpr size_t WS_VMB = al256(WS_KMB + (size_t)2 * 8 * 8192 * 64 * 2);
constexpr size_t WS_KSB = al256(WS_VMB + (size_t)2 * 8 * 8192 * 64 * 2);
constexpr size_t WS_VSB = al256(WS_KSB + (size_t)2 * 2 * 8192 * 64 * 2);
constexpr size_t WS_KWB = al256(WS_VSB + (size_t)2 * 2 * 8192 * 64 * 2);
constexpr size_t WS_VWB = al256(WS_KWB + (size_t)2 * 2 * 8192 * 64 * 2);
constexpr size_t WS_CKB = al256(WS_VWB + (size_t)2 * 2 * 8192 * 64 * 2);
constexpr size_t WS_CVB = al256(WS_CKB + (size_t)34 * 2 * 512 * 64 * 2);
constexpr size_t WS_MIXED = al256(WS_CVB + (size_t)34 * 2 * 512 * 64 * 2);
constexpr size_t WS_XNEW = al256(WS_MIXED + (size_t)NT * 1024 * 2);
constexpr size_t WS_SEL = al256(WS_XNEW + (size_t)NT * 1024 * 4);
constexpr size_t WS_LIST = al256(WS_SEL + (size_t)2 * 8 * 8192 * 4);
constexpr size_t WS_PART = al256(WS_LIST + (size_t)2 * 8 * 32 * 8192 * 2);
constexpr size_t WS_END0 = al256(WS_PART + (size_t)2 * 8 * 8192 * 3 * 68 * 4);
constexpr size_t WS_LUTG = WS_END0;
constexpr size_t WS_STAT = al256(WS_LUTG + (size_t)16 * 2 * 768 * 4);
constexpr size_t WS_END = al256(WS_STAT + (size_t)128 * 8 * 128 * 4);
constexpr size_t WS_MCNT = WS_CTR + 4096;
constexpr size_t WS_PCNT = WS_CTR + 8192;

constexpr int LDS_BYTES = 66560;
constexpr int NTHREADS = 256;

struct Params {
    const float *x_p, *x_s, *c_p, *c_s, *cache_m, *cache_n, *win_state;
    const int* page_table;
    const float *w_ada, *b_ada, *norm_gain, *w_in, *cmp_pe, *k_w1, *k_w2, *v_w1, *v_w2, *w_out, *rel_bias, *final_gain;
    float* out;
    unsigned char* ws;
};

DI bf16x8 cvt8(f32x4 a, f32x4 b) {
    f32x8 v = {a.x, a.y, a.z, a.w, b.x, b.y, b.z, b.w};
    return __builtin_bit_cast(bf16x8, __builtin_convertvector(v, bf8v));
}
DI uint2 cvt4(float a, float b, float c, float d) {
    f32x4 v = {a, b, c, d};
    return __builtin_bit_cast(uint2, __builtin_convertvector(v, bf4v));
}
DI u16 cvt1(float a) { __bf16 h = (__bf16)a; return __builtin_bit_cast(u16, h); }
DI float bf2f(u16 u) { return __uint_as_float((unsigned)u << 16); }
DI float fexp2(float x) { return __builtin_amdgcn_exp2f(x); }
DI float silu_f(float z) { return z / (1.f + __expf(-z)); }
DI float sigmoid_f(float z) { return 1.f / (1.f + __expf(-z)); }
DI int crow(int i, int h) { return (i & 3) + 8 * (i >> 2) + 4 * h; }
DI f32x16 mfma32(bf16x8 a, bf16x8 b, f32x16 c) { return __builtin_amdgcn_mfma_f32_32x32x16_bf16(a, b, c, 0, 0, 0); }
DI float wave_sum(float v) {
#pragma unroll
    for (int o = 1; o < 64; o <<= 1) v += __shfl_xor(v, o);
    return v;
}
DI int opaque(int v) { asm volatile("" : "+v"(v)); return v; }
DI int opaque_s(int v) { asm volatile("" : "+s"(v)); return v; }
DI f32x16 zero16() { f32x16 z; for (int i = 0; i < 16; ++i) z[i] = 0.f; return z; }
DI s16x4 tr_read(const char* p) {
    return __builtin_amdgcn_ds_read_tr16_b64_v4i16((LAS s16x4*)(LAS char*)p);
}

#define XB_TMO      128
#define XB_XCNT(j)  (256  + 64 * (j))
#define XB_XSUB(j)  (1280 + 64 * (j))
#define XB_XGEN(j)  (2304 + 64 * (j))
#define XB_TOP      3328
#define XB_TOPGEN   3392
#define XCD_BAR_WORDS 3456
#define XB_SPIN_CAP (1u << 22)

DI unsigned xb_ld(unsigned* p)              { return __hip_atomic_load(p, __ATOMIC_RELAXED, __HIP_MEMORY_SCOPE_AGENT); }
DI unsigned xb_add(unsigned* p, unsigned v) { return __hip_atomic_fetch_add(p, v, __ATOMIC_RELAXED, __HIP_MEMORY_SCOPE_AGENT); }
DI unsigned xb_xcc_id() { return (unsigned)__builtin_amdgcn_s_getreg((3 << 11) | 20) & 0xFu; }
#define XB_SPIN(cond, bar) do { unsigned _sp = 0; while (cond) { __builtin_amdgcn_s_sleep(1); \
    if ((++_sp & 255u) == 0u) { if (xb_ld(&(bar)[XB_TMO])) break; if (_sp > XB_SPIN_CAP) { atomicAdd(&(bar)[XB_TMO], 1u); break; } } } } while (0)

struct XcdBarrier { unsigned* bar; unsigned x; volatile LAS unsigned* st; };

DI XcdBarrier xcd_barrier_post(unsigned* bar, volatile LAS unsigned* st) {
    XcdBarrier b; b.bar = bar; b.x = xb_xcc_id(); b.st = st;
    if (threadIdx.x == 0) (void)xb_add(&bar[XB_XCNT(b.x)], 1u);
    return b;
}
DI void xcd_barrier_complete(unsigned* bar, unsigned x, unsigned& nloc, unsigned& nx) {
    const unsigned G = gridDim.x * gridDim.y * gridDim.z;
    unsigned sum, cnt, mine, sp = 0u;
    for (;;) {
        sum = 0u; cnt = 0u; mine = 0u;
#pragma unroll
        for (unsigned j = 0; j < 16; ++j) { const unsigned c = xb_ld(&bar[XB_XCNT(j)]); sum += c; cnt += (c > 0u) ? 1u : 0u; mine = (j == x) ? c : mine; }
        if (sum == G) break;
        __builtin_amdgcn_s_sleep(1);
        if ((++sp & 255u) == 0u) { if (xb_ld(&bar[XB_TMO])) break; if (sp > XB_SPIN_CAP) { atomicAdd(&bar[XB_TMO], 1u); break; } }
    }
    nloc = mine > 0u ? mine : 1u; nx = cnt > 0u ? cnt : 1u;
}
DI void xcd_barrier(const XcdBarrier& b) {
    asm volatile("s_waitcnt vmcnt(0)" ::: "memory");
    __syncthreads();
    if (threadIdx.x == 0) {
        unsigned* bar = b.bar;
        __builtin_amdgcn_s_waitcnt(0);
        unsigned nloc = b.st[0], nx = b.st[1];
        if (nloc == 0u) { xcd_barrier_complete(bar, b.x, nloc, nx); b.st[0] = nloc; b.st[1] = nx; }
        const unsigned old = xb_add(&bar[XB_XSUB(b.x)], 1u);
        const unsigned gen = old / nloc;
        if (old + 1u == (gen + 1u) * nloc) {
            __builtin_amdgcn_fence(__ATOMIC_RELEASE, "agent");
            asm volatile("s_waitcnt vmcnt(0)" ::: "memory");
            const unsigned og = xb_add(&bar[XB_TOP], 1u);
            const unsigned tg = og / nx;
            if (og + 1u == (tg + 1u) * nx) xb_add(&bar[XB_TOPGEN], 1u);
            else XB_SPIN(xb_ld(&bar[XB_TOPGEN]) == tg, bar);
            __builtin_amdgcn_fence(__ATOMIC_ACQUIRE, "agent");
            xb_add(&bar[XB_XGEN(b.x)], 1u);
            asm volatile("s_waitcnt vmcnt(0)" ::: "memory");
        } else {
            XB_SPIN(xb_ld(&bar[XB_XGEN(b.x)]) == gen, bar);
            __builtin_amdgcn_fence(__ATOMIC_ACQUIRE, "agent");
            asm volatile("s_waitcnt vmcnt(0)" ::: "memory");
        }
    }
    __syncthreads();
}

DI int t5_bucket(int n) {
    if (n < 16) return n;
    int b = 16;
    b += n >= 19; b += n >= 21; b += n >= 24; b += n >= 27; b += n >= 31; b += n >= 35; b += n >= 40; b += n >= 46;
    b += n >= 52; b += n >= 59; b += n >= 67; b += n >= 77; b += n >= 87; b += n >= 99; b += n >= 113;
    return b;
}

constexpr int LW = 768;
DI int perm_in(int n) { return n < 3328 ? n : (n < 3352 ? 3840 + (n - 3328) : n - 24); }

DI void transpose_item(const float* __restrict__ W, int K, int N, u16* __restrict__ WT, int kt, int nt, bool perm, char* sm) {
    float* scr = (float*)sm;
    const int t = opaque(threadIdx.x);
    const int k0 = kt * 64, n0 = nt * 64;
#pragma unroll 4
    for (int i = 0; i < 16; ++i) {
        const int kk = (t >> 6) + 4 * i, n = n0 + (t & 63);
        scr[kk * 65 + (t & 63)] = (n < N) ? W[(size_t)(k0 + kk) * N + n] : 0.f;
    }
    __syncthreads();
    const int nl = t >> 2, kc = (t & 3) * 16, nn = n0 + nl;
    if (nn < N) {
        const int np = perm ? perm_in(nn) : nn;
        float v[16];
#pragma unroll
        for (int j = 0; j < 16; ++j) v[j] = scr[(kc + j) * 65 + nl];
        f32x4 a = {v[0], v[1], v[2], v[3]}, b = {v[4], v[5], v[6], v[7]}, c = {v[8], v[9], v[10], v[11]}, d = {v[12], v[13], v[14], v[15]};
        bf16x8* dst = (bf16x8*)(WT + (size_t)np * K + k0 + kc);
        dst[0] = cvt8(a, b); dst[1] = cvt8(c, d);
    }
    __syncthreads();
}

DI void kmean_item(const float* __restrict__ base, const int* __restrict__ pt, int b, int n, float* __restrict__ outp, char* sm) {
    float* scr = (float*)sm;
    const int t = opaque(threadIdx.x), lane = t & 63, w = t >> 6;
    f32x4 a0 = {0.f, 0.f, 0.f, 0.f}, a1 = {0.f, 0.f, 0.f, 0.f};
#pragma unroll
    for (int hf = 0; hf < 2; ++hf) {
        const int pos0 = n * 256 + hf * 128;
        const size_t r0 = pt ? (size_t)pt[b * 64 + (pos0 >> 7)] * 128 : (size_t)b * 8192 + pos0;
        const float* rp = base + (r0 + w) * 1024 + lane * 4;
#pragma unroll 4
        for (int rr = 0; rr < 32; ++rr) {
            a0 += __builtin_nontemporal_load((const f32x4*)(rp + (size_t)rr * 4096));
            a1 += __builtin_nontemporal_load((const f32x4*)(rp + (size_t)rr * 4096 + 256));
        }
    }
    *(f32x4*)(scr + w * 512 + lane * 4) = a0;
    *(f32x4*)(scr + w * 512 + 256 + lane * 4) = a1;
    __syncthreads();
#pragma unroll
    for (int j = 0; j < 2; ++j) {
        const int col = t + 256 * j;
        outp[col] = (scr[col] + scr[512 + col] + scr[1024 + col] + scr[1536 + col]) * (1.f / 256.f);
    }
    __syncthreads();
}

DI void ada_item(const Params& p, int item, char* sm) {
    float* scr = (float*)sm;
    float* mod = (float*)(p.ws + WS_MOD);
    const int t = opaque(threadIdx.x), cl = t & 15, kg = t >> 4, col0 = item * 16;
    float acc[36];
#pragma unroll
    for (int i = 0; i < 36; ++i) acc[i] = 0.f;
    for (int pass = 0; pass < 4; ++pass) {
#pragma unroll
        for (int bb = 0; bb < 34; ++bb) scr[t * 36 + bb] = bb < 2 ? p.c_p[bb * 1024 + pass * 256 + t] : p.c_s[(bb - 2) * 1024 + pass * 256 + t];
        if (pass == 0) { scr[t * 36 + 34] = 0.f; scr[t * 36 + 35] = 0.f; }
        __syncthreads();
        float wv[16];
#pragma unroll
        for (int kk = 0; kk < 16; ++kk) wv[kk] = p.w_ada[(size_t)(pass * 256 + kk * 16 + kg) * 3072 + col0 + cl];
#pragma unroll
        for (int kk = 0; kk < 16; ++kk) {
            const float* cr = scr + (kk * 16 + kg) * 36;
#pragma unroll
            for (int j = 0; j < 9; ++j) {
                const f32x4 c4 = *(const f32x4*)(cr + 4 * j);
                acc[4 * j] += c4.x * wv[kk]; acc[4 * j + 1] += c4.y * wv[kk]; acc[4 * j + 2] += c4.z * wv[kk]; acc[4 * j + 3] += c4.w * wv[kk];
            }
        }
        __syncthreads();
    }
#pragma unroll
    for (int bb = 0; bb < 34; ++bb) scr[(kg * 34 + bb) * 16 + cl] = acc[bb];
    __syncthreads();
    for (int o = t; o < 34 * 16; o += 256) {
        const int bb = o >> 4, c2 = o & 15;
        float s = p.b_ada[col0 + c2];
#pragma unroll
        for (int g = 0; g < 16; ++g) s += scr[(g * 34 + bb) * 16 + c2];
        mod[bb * 3072 + col0 + c2] = s;
    }
    __syncthreads();
}

constexpr int P0_KMS = 1024, P0_TWIN = 16 * 61, P0_TWOUT = 256, P0_W1 = 64, P0_W2 = 2, P0_ADA = 192, P0_WCP = 128, P0_PAD = 13, P0_LUT = 16;
constexpr int P0_ITEMS = P0_KMS + P0_TWIN + P0_TWOUT + 2 * P0_W1 + 2 * P0_W2 + P0_ADA + P0_WCP + P0_PAD + P0_LUT;

DI void phase0(const Params& p, char* sm, int msk = 15) {
    for (int it = blockIdx.x; it < P0_ITEMS; it += gridDim.x) {
        const int t = opaque(threadIdx.x);
        int r = it;
        if (r < P0_ADA) { if (msk & 1) ada_item(p, r, sm); continue; } r -= P0_ADA;
        if (r < P0_KMS) { if (msk & 2) kmean_item(p.cache_m, p.page_table, r >> 5, r & 31, (float*)(p.ws + WS_KMS) + (size_t)r * 512, sm); continue; } r -= P0_KMS;
        if (r < P0_TWIN + P0_TWOUT + 2 * P0_W1 + 2 * P0_W2) { if (!(msk & 4)) continue; } else if (!(msk & 8)) continue;
        if (r < P0_TWIN) { transpose_item(p.w_in, 1024, 3864, (u16*)(p.ws + WS_WTIN), r / 61, r % 61, true, sm); continue; } r -= P0_TWIN;
        if (r < P0_TWOUT) { transpose_item(p.w_out, 1024, 1024, (u16*)(p.ws + WS_WTOUT), r >> 4, r & 15, false, sm); continue; } r -= P0_TWOUT;
        if (r < P0_W1) { transpose_item(p.k_w1, 2048, 128, (u16*)(p.ws + WS_WC1K), r >> 1, r & 1, false, sm); continue; } r -= P0_W1;
        if (r < P0_W1) { transpose_item(p.v_w1, 2048, 128, (u16*)(p.ws + WS_WC1V), r >> 1, r & 1, false, sm); continue; } r -= P0_W1;
        if (r < P0_W2) { transpose_item(p.k_w2, 128, 64, (u16*)(p.ws + WS_WC2K), r, 0, false, sm); continue; } r -= P0_W2;
        if (r < P0_W2) { transpose_item(p.v_w2, 128, 64, (u16*)(p.ws + WS_WC2V), r, 0, false, sm); continue; } r -= P0_W2;
        if (r < P0_WCP) {
            const int b = r >> 2, q = r & 3;
            const f32x4* src = (const f32x4*)(p.win_state + ((size_t)b * 512 + 4) * 256) + q * 8128;
            f32x4* dst = (f32x4*)(p.out + O_WS + (size_t)b * 512 * 256) + q * 8128;
            for (int i0 = 0; i0 < 8128; i0 += 1024) {
                f32x4 v0, v1, v2, v3;
                const int ia = i0 + t, ib = ia + 256, ic = ia + 512, id = ia + 768;
                const int ja = ia < 8128 ? ia : 8127, jb = ib < 8128 ? ib : 8127, jc = ic < 8128 ? ic : 8127, jd = id < 8128 ? id : 8127;
                v0 = __builtin_nontemporal_load(src + ja); v1 = __builtin_nontemporal_load(src + jb);
                v2 = __builtin_nontemporal_load(src + jc); v3 = __builtin_nontemporal_load(src + jd);
                dst[ja] = v0; dst[jb] = v1; dst[jc] = v2; dst[jd] = v3;
            }
            continue;
        } r -= P0_WCP;
        if (r >= P0_PAD) {
            const int hd = r - P0_PAD;
            float* lg = (float*)(p.ws + WS_LUTG) + (size_t)hd * 2 * LW;
            for (int i = t; i < 2 * LW; i += 256) {
                const int var = i >= LW, rel = (var ? i - LW : i) - 128;
                const float bias = p.rel_bias[t5_bucket(rel < 0 ? 0 : (rel > 127 ? 127 : rel)) * 16 + hd] * LOG2E;
                lg[i] = (rel < 0 || (var && rel >= 512)) ? -1e30f : bias;
            }
            continue;
        }
        {
            uint4* dst = (uint4*)(p.ws + WS_WTIN + (size_t)3864 * 2048) + (size_t)r * 1024;
            const uint4 z = {0u, 0u, 0u, 0u};
            for (int i = t; i < 1024; i += 256) dst[i] = z;
        }
    }
}

DI void phase1(const Params& p, char* sm) {
    const int tt_ = opaque(threadIdx.x), lane = tt_ & 63, w = tt_ >> 6;
    const float* mod = (const float*)(p.ws + WS_MOD);
    u16* H = (u16*)(p.ws + WS_H);
    for (int row = blockIdx.x * 4 + w; row < NT; row += gridDim.x * 4) {
        const float* xr = row < NP ? p.x_p + (size_t)row * 1024 : p.x_s + (size_t)(row - NP) * 1024;
        const int mb = row < NP ? (row >> 13) : 2 + ((row - NP) >> 2);
        f32x4 v[4]; float ss = 0.f;
#pragma unroll
        for (int j = 0; j < 4; ++j) { v[j] = *(const f32x4*)(xr + lane * 4 + 256 * j); ss += v[j].x * v[j].x + v[j].y * v[j].y + v[j].z * v[j].z + v[j].w * v[j].w; }
        ss = wave_sum(ss);
        const float inv = rsqrtf(ss * (1.f / 1024.f) + 1e-6f);
#pragma unroll
        for (int j = 0; j < 4; ++j) {
            const int col = lane * 4 + 256 * j;
            const f32x4 g = *(const f32x4*)(p.norm_gain + col);
            const f32x4 sh = *(const f32x4*)(mod + mb * 3072 + col);
            const f32x4 sc = *(const f32x4*)(mod + mb * 3072 + 1024 + col);
            const float h0 = (v[j].x * inv) * g.x * (1.f + sc.x) + sh.x;
            const float h1 = (v[j].y * inv) * g.y * (1.f + sc.y) + sh.y;
            const float h2 = (v[j].z * inv) * g.z * (1.f + sc.z) + sh.z;
            const float h3 = (v[j].w * inv) * g.w * (1.f + sc.w) + sh.w;
            *(uint2*)(H + (size_t)row * 1024 + col) = cvt4(h0, h1, h2, h3);
        }
    }
}

struct TileSrc {
    const float* base; const int* pt; const float* base_new;
    int P, ld, newbs, kcol, vcol, b, posoff, maxsrc;
};
DI const float* ts_row(const TileSrc& s, int kpos) {
    int sp = kpos - s.posoff; sp = sp < 0 ? 0 : (sp > s.maxsrc ? s.maxsrc : sp);
    if (sp < s.P) {
        const size_t r = s.pt ? (size_t)s.pt[s.b * 64 + (sp >> 7)] * 128 + (sp & 127) : (size_t)s.b * s.P + sp;
        return s.base + r * s.ld;
    }
    return s.base_new + ((size_t)s.b * s.newbs + (sp - s.P)) * s.ld;
}

struct ALoadBf16 {
    const u16* A; int lda; int m0;
    struct Raw { bf16x8 v[4]; };
    static DI int kmap(int kt) { return kt; }
    DI void load(Raw& R, int kt) const {
        const int t = opaque(threadIdx.x), lrow = t >> 3, lch = t & 7;
#pragma unroll
        for (int i = 0; i < 4; ++i) R.v[i] = *(const bf16x8*)(A + (size_t)(m0 + lrow + 32 * i) * lda + kt * 64 + lch * 8);
    }
    DI void cvt(const Raw& R, bf16x8 (&o)[4], int) const {
#pragma unroll
        for (int i = 0; i < 4; ++i) o[i] = R.v[i];
    }
};
struct ALoadCmp {
    const float* base; const float* pe; int col; int pg0[2], pg1[2], pos0[2];
    struct Raw { f32x4 a[4], b[4]; };
    static DI int kmap(int kt) { return (kt >> 1) + 16 * (kt & 1); }
    DI void init(const float* base_, const int* pt, int b, int i0, int kv, const float* pe_) {
        base = base_; pe = pe_; col = kv * 128;
        const int lrow = opaque(threadIdx.x) >> 3;
#pragma unroll
        for (int j = 0; j < 2; ++j) {
            int blk = i0 + lrow + 32 * j; blk = blk > 510 ? 510 : blk;
            pos0[j] = 16 * blk;
            const int pg = pos0[j] >> 7, pgn = pg < 63 ? pg + 1 : 63;
            pg0[j] = pt ? pt[b * 64 + pg] : b * 64 + pg;
            pg1[j] = pt ? pt[b * 64 + pgn] : b * 64 + pgn;
        }
    }
    DI void load(Raw& R, int kt) const {
        const int lch = opaque(threadIdx.x) & 7;
#pragma unroll
        for (int j = 0; j < 2; ++j) {
            const int pos = pos0[j] + kt;
            const int pg = (pos >> 7) == (pos0[j] >> 7) ? pg0[j] : pg1[j];
            const float* rp = base + ((size_t)pg * 128 + (pos & 127)) * 512 + col + lch * 8;
            R.a[j] = *(const f32x4*)rp; R.b[j] = *(const f32x4*)(rp + 4);
            R.a[j + 2] = *(const f32x4*)(rp + 64); R.b[j + 2] = *(const f32x4*)(rp + 68);
        }
    }
    DI void cvt(const Raw& R, bf16x8 (&o)[4], int kt) const {
        const int lch = opaque(threadIdx.x) & 7;
        const f32x4 pe0 = *(const f32x4*)(pe + kt * 64 + lch * 8), pe1 = *(const f32x4*)(pe + kt * 64 + lch * 8 + 4);
#pragma unroll
        for (int i = 0; i < 4; ++i) o[i] = cvt8(R.a[i] + pe0, R.b[i] + pe1);
    }
};

template <class AL> struct GemmRegs { typename AL::Raw RA0, RA1; bf16x8 RB0[4], RB1[4]; };
template <class AL>
DI void gemm_mainloop(f32x16 (&acc)[2][2], GemmRegs<AL>& G, bool pre, const AL& al, const u16* __restrict__ Bt, int ldb, int n0, int nk, char* sm,
                      bool has_next, const AL& aln, int n0n) {
    const int t = opaque(threadIdx.x), lane = t & 63, w = t >> 6;
    const int wm = w >> 1, wn = w & 1, r = lane & 31, h = lane >> 5;
    const int lrow = t >> 3, lch = t & 7;
    typename AL::Raw& RA0 = G.RA0; typename AL::Raw& RA1 = G.RA1;
    bf16x8 (&RB0)[4] = G.RB0; bf16x8 (&RB1)[4] = G.RB1;
    const u16* bp = Bt + (size_t)(n0 + lrow) * ldb + lch * 8;
    const u16* bpn = Bt + (size_t)(n0n + lrow) * ldb + lch * 8;
    auto loadB = [&](bf16x8 (&rb)[4], int kt) {
#pragma unroll
        for (int i = 0; i < 4; ++i) rb[i] = *(const bf16x8*)(bp + (size_t)(32 * i) * ldb + kt * 64);
    };
    auto loadBn = [&](bf16x8 (&rb)[4], int kt) {
#pragma unroll
        for (int i = 0; i < 4; ++i) rb[i] = *(const bf16x8*)(bpn + (size_t)(32 * i) * ldb + kt * 64);
    };
    auto store = [&](const typename AL::Raw& RA, const bf16x8 (&rb)[4], int kt, char* dA) {
        bf16x8 ra[4];
        al.cvt(RA, ra, AL::kmap(kt));
#pragma unroll
        for (int i = 0; i < 4; ++i) {
            const int row = lrow + 32 * i;
            const int off = row * 128 + ((lch ^ ((row >> 1) & 7)) << 4);
            *(bf16x8*)(dA + off) = ra[i];
            *(bf16x8*)(dA + 16384 + off) = rb[i];
        }
    };
    auto compute = [&](const char* cA) {
        const char* cB = cA + 16384;
        bf16x8 a[2][2], b[2][2];
        auto rd = [&](int set, int ks) {
#pragma unroll
            for (int mi = 0; mi < 2; ++mi) { const int row = wm * 64 + mi * 32 + r; a[set][mi] = *(const bf16x8*)(cA + row * 128 + (((2 * ks + h) ^ ((row >> 1) & 7)) << 4)); }
#pragma unroll
            for (int ni = 0; ni < 2; ++ni) { const int row = wn * 64 + ni * 32 + r; b[set][ni] = *(const bf16x8*)(cB + row * 128 + (((2 * ks + h) ^ ((row >> 1) & 7)) << 4)); }
        };
        auto mm = [&](int set) {
#pragma unroll
            for (int mi = 0; mi < 2; ++mi)
#pragma unroll
                for (int ni = 0; ni < 2; ++ni) acc[mi][ni] = mfma32(a[set][mi], b[set][ni], acc[mi][ni]);
        };
        rd(0, 0); rd(1, 1);
        __builtin_amdgcn_sched_barrier(0);
        mm(0); rd(0, 2);
        __builtin_amdgcn_sched_barrier(0);
        mm(1); rd(1, 3);
        __builtin_amdgcn_sched_barrier(0);
        mm(0); mm(1);
    };
    char* buf0 = sm; char* buf1 = sm + 32768;
    if (!pre) {
        al.load(RA0, AL::kmap(0)); loadB(RB0, AL::kmap(0));
        al.load(RA1, AL::kmap(1)); loadB(RB1, AL::kmap(1));
    }
    store(RA0, RB0, 0, buf0);
    __syncthreads();
    if (2 < nk) { al.load(RA0, AL::kmap(2)); loadB(RB0, AL::kmap(2)); }
    for (int kt = 0; kt < nk; kt += 2) {
        compute(buf0);
        store(RA1, RB1, kt + 1, buf1);
        if (kt + 3 < nk) { al.load(RA1, AL::kmap(kt + 3)); loadB(RB1, AL::kmap(kt + 3)); }
        else if (has_next) { aln.load(RA1, AL::kmap(1)); loadBn(RB1, AL::kmap(1)); }
        __syncthreads();
        compute(buf1);
        if (kt + 2 < nk) {
            store(RA0, RB0, kt + 2, buf0);
            if (kt + 4 < nk) { al.load(RA0, AL::kmap(kt + 4)); loadB(RB0, AL::kmap(kt + 4)); }
            else if (has_next) { aln.load(RA0, AL::kmap(0)); loadBn(RB0, AL::kmap(0)); }
        }
        __syncthreads();
    }
}

template <int LD, int MODE>
DI void epi_store(const f32x16 (&acc)[2][2], float* fb, u16* bb) {
#pragma unroll
    for (int mi = 0; mi < 2; ++mi)
#pragma unroll
        for (int ni = 0; ni < 2; ++ni)
#pragma unroll
            for (int i = 0; i < 16; ++i) {
                const int off = (mi * 32 + (i & 3) + 8 * (i >> 2)) * LD + ni * 32;
                const float v = acc[mi][ni][i];
                if (MODE == 0) fb[off] = v;
                else if (MODE == 1) bb[off] = cvt1(v);
                else bb[off] = cvt1(silu_f(v));
            }
}

DI void gemm1_tile(const Params& p, GemmRegs<ALoadBf16>& G, bool pre, int tm, int tn, bool has_next, int tmn, int tnn, char* sm) {
    f32x16 acc[2][2];
#pragma unroll
    for (int a = 0; a < 2; ++a)
#pragma unroll
        for (int b = 0; b < 2; ++b) acc[a][b] = zero16();
    ALoadBf16 al{(const u16*)(p.ws + WS_H), 1024, tm * 128};
    ALoadBf16 aln{(const u16*)(p.ws + WS_H), 1024, tmn * 128};
    gemm_mainloop(acc, G, pre, al, (const u16*)(p.ws + WS_WTIN), 1024, tn * 128, 16, sm, has_next, aln, tnn * 128);
    const int t_ = opaque(threadIdx.x), lane = t_ & 63, w = t_ >> 6, wm = w >> 1, wn = w & 1, r = lane & 31, h = lane >> 5;
    const bool smp = tm == 128;
    const size_t rloc = (size_t)(smp ? 0 : tm * 128) + wm * 64 + 4 * h;
    const size_t rall = (size_t)tm * 128 + wm * 64 + 4 * h;
    const int cl = wn * 64 + r;
    if (tn < 4) epi_store<512, 1>(acc, nullptr, (u16*)(p.ws + WS_QM) + rall * 512 + tn * 128 + cl);
    else if (tn < 12) {
        epi_store<1024, 0>(acc, p.out + (smp ? O_MKS : O_MKP) + rloc * 1024 + (tn - 4) * 128 + cl, nullptr);
        if (!smp) {
            u16* dst = (u16*)(p.ws + (tn < 8 ? WS_KMB : WS_VMB)) + (((size_t)(tm >> 6) * 8 + 2 * (tn & 3) + wn) * 8192 + (tm & 63) * 128 + wm * 64 + 4 * h) * 64 + r;
            epi_store<64, 1>(acc, nullptr, dst);
            if (tn < 8) {
                float* kp = (float*)(p.ws + WS_KMP) + ((((size_t)(tm >> 6) * 32 + ((tm & 63) >> 1)) * 4 + (tm & 1) * 2 + wm) * 512) + (tn - 4) * 128 + cl;
#pragma unroll
                for (int ni = 0; ni < 2; ++ni) {
                    float cs = 0.f;
#pragma unroll
                    for (int mi = 0; mi < 2; ++mi)
#pragma unroll
                        for (int i = 0; i < 16; ++i) cs += acc[mi][ni][i];
                    cs += __shfl_xor(cs, 32);
                    if (h == 0) kp[ni * 32] = cs;
                }
            }
        }
    }
    else if (tn < 16) epi_store<512, 2>(acc, nullptr, (u16*)(p.ws + WS_ZM) + rall * 512 + (tn - 12) * 128 + cl);
    else if (tn < 20) epi_store<512, 1>(acc, nullptr, (u16*)(p.ws + WS_QN) + rall * 512 + (tn - 16) * 128 + cl);
    else if (tn < 24) {
        epi_store<512, 0>(acc, p.out + (smp ? O_NKS : O_NKP) + rloc * 512 + (tn - 20) * 128 + cl, nullptr);
        if (!smp && tn >= 22) {
            u16* dst = (u16*)(p.ws + (tn == 22 ? WS_KSB : WS_VSB)) + (((size_t)(tm >> 6) * 2 + wn) * 8192 + (tm & 63) * 128 + wm * 64 + 4 * h) * 64 + r;
            epi_store<64, 1>(acc, nullptr, dst);
        }
    }
    else if (tn < 26) {
        const int coff = (tn - 24) * 128 + cl;
        if (smp) {
            float* fb = p.out + O_WS + ((size_t)(wm * 16 + h) * 512 + 508) * 256 + coff;
#pragma unroll
            for (int mi = 0; mi < 2; ++mi)
#pragma unroll
                for (int ni = 0; ni < 2; ++ni)
#pragma unroll
                    for (int i = 0; i < 16; ++i) fb[((mi * 8 + 2 * (i >> 2)) * 512 + (i & 3)) * 256 + ni * 32] = acc[mi][ni][i];
        } else {
            u16* dst = (u16*)(p.ws + (tn == 24 ? WS_KWB : WS_VWB)) + (((size_t)(tm >> 6) * 2 + wn) * 8192 + (tm & 63) * 128 + wm * 64 + 4 * h) * 64 + r;
            epi_store<64, 1>(acc, nullptr, dst);
            if ((tm & 63) >= 60)
                epi_store<256, 0>(acc, p.out + O_WP + ((size_t)(tm >> 6) * 512 + ((tm & 63) - 60) * 128 + wm * 64 + 4 * h) * 256 + coff, nullptr);
        }
    }
    else if (tn < 30) epi_store<512, 2>(acc, nullptr, (u16*)(p.ws + WS_ZN) + rall * 512 + (tn - 26) * 128 + cl);
    else {
        if (wn == 0 && r < 24) {
            float* gb = (float*)(p.ws + WS_GATES) + rall * 24 + r;
#pragma unroll
            for (int mi = 0; mi < 2; ++mi)
#pragma unroll
                for (int i = 0; i < 16; ++i) gb[(mi * 32 + (i & 3) + 8 * (i >> 2)) * 24] = sigmoid_f(acc[mi][0][i]);
        }
    }
}

template <int CTRL> DI float dpp_mov(float v) {
    return __builtin_bit_cast(float, __builtin_amdgcn_update_dpp(0, __builtin_bit_cast(int, v), CTRL, 0xF, 0xF, true));
}
DI float row16_sum(float v) {
    v += dpp_mov<0xB1>(v); v += dpp_mov<0x4E>(v); v += dpp_mov<0x141>(v); v += dpp_mov<0x140>(v);
    return v;
}

template <bool SMP>
DI void gemm2_tile(const Params& p, GemmRegs<ALoadBf16>& G, bool pre, int tm, int tn, bool has_next, int tmn, int tnn, char* sm) {
    f32x16 acc[2][2];
#pragma unroll
    for (int a = 0; a < 2; ++a)
#pragma unroll
        for (int b = 0; b < 2; ++b) acc[a][b] = zero16();
    ALoadBf16 al{(const u16*)(p.ws + WS_MIXED), 1024, tm * 128};
    ALoadBf16 aln{(const u16*)(p.ws + WS_MIXED), 1024, tmn * 128};
    gemm_mainloop(acc, G, pre, al, (const u16*)(p.ws + WS_WTOUT), 1024, tn * 128, 16, sm, has_next, aln, tnn * 128);
    const int t_ = opaque(threadIdx.x), lane = t_ & 63, w = t_ >> 6, wm = w >> 1, wn = w & 1, r = lane & 31, h = lane >> 5;
    const float* mod = (const float*)(p.ws + WS_MOD);
    const int col = tn * 128 + wn * 64 + r;
    if (!SMP) {
        const size_t row0 = (size_t)tm * 128 + wm * 64 + 4 * h;
        const float* xb = p.x_p + row0 * 1024 + col;
        const float* gb = mod + (size_t)(tm >> 6) * 3072 + 2048 + col;
        float* srow = (float*)(sm + 32768);
#pragma unroll
        for (int mi = 0; mi < 2; ++mi)
#pragma unroll
            for (int ni = 0; ni < 2; ++ni) {
                float xv[16];
                const float gv = gb[ni * 32];
#pragma unroll
                for (int i = 0; i < 16; ++i) xv[i] = __builtin_nontemporal_load(xb + (mi * 32 + (i & 3) + 8 * (i >> 2)) * 1024 + ni * 32);
#pragma unroll
                for (int i = 0; i < 16; ++i) acc[mi][ni][i] = xv[i] + gv * acc[mi][ni][i];
            }
#pragma unroll
        for (int mi = 0; mi < 2; ++mi)
#pragma unroll
            for (int i = 0; i < 16; ++i) {
                float ss = acc[mi][0][i] * acc[mi][0][i] + acc[mi][1][i] * acc[mi][1][i];
                ss = row16_sum(ss);
                ss += __shfl_xor(ss, 16);
                if (r == 0) srow[wn * 128 + wm * 64 + mi * 32 + crow(i, h)] = ss;
            }
        __syncthreads();
        unsigned* stats = (unsigned*)(p.ws + WS_STAT) + (size_t)tm * 1024;
        unsigned* pc = (unsigned*)(p.ws + WS_PCNT) + tm * 8;
        if (t_ < 128) {
            __hip_atomic_store(stats + tn * 128 + t_, __float_as_uint(srow[t_] + srow[128 + t_]), __ATOMIC_RELAXED, __HIP_MEMORY_SCOPE_AGENT);
            asm volatile("s_waitcnt vmcnt(0)" ::: "memory");
            if (lane == 0) (void)xb_add(pc, 1u);
        }
        if (t_ == 0) {
            unsigned sp = 0u;
            while (xb_ld(pc) < 16u) { __builtin_amdgcn_s_sleep(1); if (++sp > XB_SPIN_CAP) break; }
            __builtin_amdgcn_fence(__ATOMIC_ACQUIRE, "agent");
            asm volatile("s_waitcnt vmcnt(0)" ::: "memory");
        }
        __syncthreads();
        if (t_ < 128) {
            float tot = 0.f;
#pragma unroll
            for (int q = 0; q < 8; ++q) tot += __uint_as_float(__hip_atomic_load(stats + q * 128 + t_, __ATOMIC_RELAXED, __HIP_MEMORY_SCOPE_AGENT));
            srow[256 + t_] = rsqrtf(tot * (1.f / 1024.f) + 1e-6f);
        }
        __syncthreads();
        const float fg0 = p.final_gain[col], fg1 = p.final_gain[col + 32];
        float* yb = p.out + O_YP + row0 * 1024 + col;
#pragma unroll
        for (int mi = 0; mi < 2; ++mi)
#pragma unroll
            for (int i = 0; i < 16; ++i) {
                const int ro = mi * 32 + (i & 3) + 8 * (i >> 2);
                const float inv = srow[256 + wm * 64 + 4 * h + ro];
                yb[ro * 1024] = acc[mi][0][i] * inv * fg0;
                yb[ro * 1024 + 32] = acc[mi][1][i] * inv * fg1;
            }
        return;
    }
    const bool smp = true;
    const size_t rloc = (size_t)(smp ? 0 : tm * 128) + wm * 64 + 4 * h;
    const float* xb = (smp ? p.x_s : p.x_p) + rloc * 1024 + col;
    float* ob = (float*)(p.ws + WS_XNEW) + ((size_t)tm * 128 + wm * 64 + 4 * h) * 1024 + col;
    const float* gb = mod + (size_t)(smp ? 2 + wm * 16 + h : (tm >> 6)) * 3072 + 2048 + col;
#pragma unroll
    for (int mi = 0; mi < 2; ++mi)
#pragma unroll
        for (int ni = 0; ni < 2; ++ni) {
            float xv[16], gv[16];
#pragma unroll
            for (int i = 0; i < 16; ++i) {
                const int off = (mi * 32 + (i & 3) + 8 * (i >> 2)) * 1024 + ni * 32;
                xv[i] = __builtin_nontemporal_load(xb + off);
                gv[i] = smp ? gb[(mi * 8 + 2 * (i >> 2)) * 3072 + ni * 32] : gb[ni * 32];
            }
#pragma unroll
            for (int i = 0; i < 16; ++i) {
                const int off = (mi * 32 + (i & 3) + 8 * (i >> 2)) * 1024 + ni * 32;
                ob[off] = xv[i] + gv[i] * acc[mi][ni][i];
            }
        }
}

DI void compress_item(const Params& p, bool dec, int kv, int b, int it8, char* sm) {
    f32x16 acc[2][2];
#pragma unroll
    for (int a = 0; a < 2; ++a)
#pragma unroll
        for (int c = 0; c < 2; ++c) acc[a][c] = zero16();
    ALoadCmp al;
    al.init(dec ? p.cache_n : p.out + O_NKP, dec ? p.page_table : nullptr, b, it8 * 64, kv, p.cmp_pe + kv * 2048);
    GemmRegs<ALoadCmp> G;
    gemm_mainloop(acc, G, false, al, (const u16*)(p.ws + (kv ? WS_WC1V : WS_WC1K)), 2048, 0, 32, sm, false, al, 0);
    const int t_ = opaque(threadIdx.x), lane = t_ & 63, w = t_ >> 6, wm = w >> 1, wn = w & 1, r = lane & 31, h = lane >> 5;
#pragma unroll
    for (int mi = 0; mi < 2; ++mi)
#pragma unroll
        for (int ni = 0; ni < 2; ++ni) {
            const int col = wn * 64 + ni * 32 + r;
#pragma unroll
            for (int i = 0; i < 16; ++i) {
                const int row = wm * 64 + mi * 32 + crow(i, h);
                *(u16*)(sm + row * 256 + ((((col >> 3) ^ (row & 15))) << 4) + (col & 7) * 2) = cvt1(silu_f(acc[mi][ni][i]));
            }
        }
    __syncthreads();
    f32x16 o2[2] = {zero16(), zero16()};
    const u16* w2t = (const u16*)(p.ws + (kv ? WS_WC2V : WS_WC2K));
    const int arow = 32 * w + r;
#pragma unroll
    for (int ks = 0; ks < 8; ++ks) {
        const bf16x8 a = *(const bf16x8*)(sm + arow * 256 + (((2 * ks + h) ^ (arow & 15)) << 4));
#pragma unroll
        for (int ni = 0; ni < 2; ++ni) {
            const bf16x8 bb = *(const bf16x8*)(w2t + (size_t)(ni * 32 + r) * 128 + 16 * ks + 8 * h);
            o2[ni] = mfma32(a, bb, o2[ni]);
        }
    }
    u16* cmp = (u16*)(p.ws + (kv ? WS_CVB : WS_CKB)) + ((size_t)((dec ? 2 + b : b) * 2 + (w >> 1)) * 512) * 64;
#pragma unroll
    for (int ni = 0; ni < 2; ++ni)
#pragma unroll
        for (int i = 0; i < 16; ++i) {
            const int blk = it8 * 64 + 32 * (w & 1) + crow(i, h);
            if (blk <= 510) cmp[(size_t)blk * 64 + ni * 32 + r] = cvt1(o2[ni][i]);
        }
    __syncthreads();
}

struct Flash { f32x16 o0, o1; float m, l; };
DI void flash_init(Flash& st) { st.o0 = zero16(); st.o1 = zero16(); st.m = -1e20f; st.l = 0.f; }

struct TileRegs { f32x4 k[4], v[4]; };
DI void tile_issue(TileRegs& R, const TileSrc& s, int pos0) {
    const int t = threadIdx.x;
    const float* rp = ts_row(s, pos0 + (t >> 2));
    const f32x4* kp = (const f32x4*)(rp + s.kcol + (t & 3) * 16);
    const f32x4* vp = (const f32x4*)(rp + s.vcol + (t & 3) * 16);
#pragma unroll
    for (int j = 0; j < 4; ++j) { R.k[j] = kp[j]; R.v[j] = vp[j]; }
}
DI void tile_store(const TileRegs& R, char* kbuf, char* vbuf) {
    const int t = threadIdx.x, key = t >> 2, q4 = t & 3, sw = (key >> 1) & 7;
    *(bf16x8*)(kbuf + key * 128 + (((2 * q4) ^ sw) << 4)) = cvt8(R.k[0], R.k[1]);
    *(bf16x8*)(kbuf + key * 128 + (((2 * q4 + 1) ^ sw) << 4)) = cvt8(R.k[2], R.k[3]);
    *(bf16x8*)(vbuf + key * 128 + (2 * q4) * 16) = cvt8(R.v[0], R.v[1]);
    *(bf16x8*)(vbuf + key * 128 + (2 * q4 + 1) * 16) = cvt8(R.v[2], R.v[3]);
}

constexpr int IMPLD = 132;

template <int MASK, bool NEAR, int PASS>
DI void flash_tile(Flash& st, const bf16x8 (&qf)[4], const char* kbuf, const char* vbuf, int pos0, int qpos, bool on,
                   const float* lut, float bfar, float* imp_row, float rinv) {
    const int lane = threadIdx.x & 63, r = lane & 31, h = lane >> 5;
    f32x16 s[2] = {zero16(), zero16()};
#pragma unroll
    for (int ks = 0; ks < 4; ++ks) {
        const int ka = r * 128 + (((2 * ks + h) ^ ((r >> 1) & 7)) << 4);
        const bf16x8 a0 = *(const bf16x8*)(kbuf + ka);
        const bf16x8 a1 = *(const bf16x8*)(kbuf + 4096 + ka);
        s[0] = mfma32(a0, qf[ks], s[0]);
        s[1] = mfma32(a1, qf[ks], s[1]);
    }
    constexpr float c1 = 0.125f * LOG2E;
    float alpha = 1.f;
    float rs = 0.f;
    if (!NEAR) {
        const float bc = MASK == 2 ? 0.f : bfar;
        float mref;
        if (PASS != 2) {
            float mr = s[0][0];
#pragma unroll
            for (int i = 1; i < 16; ++i) mr = fmaxf(mr, s[0][i]);
#pragma unroll
            for (int i = 0; i < 16; ++i) mr = fmaxf(mr, s[1][i]);
            float mx = on ? mr * c1 + bc : -1e30f;
            mx = fmaxf(mx, __shfl_xor(mx, 32));
            const float mnew = fmaxf(st.m, mx);
            alpha = fexp2(st.m - mnew);
            st.m = mnew;
            mref = mnew;
        } else mref = st.m;
        float bm = on ? bc - mref : -1e30f;
        if (PASS == 2) bm = on ? bm + __log2f(rinv) : -1e30f;
#pragma unroll
        for (int tt = 0; tt < 2; ++tt)
#pragma unroll
            for (int i = 0; i < 16; ++i) { const float pv = fexp2(s[tt][i] * c1 + bm); s[tt][i] = pv; rs += pv; }
    } else {
        float mx = -1e30f;
        if (MASK == 2) {
            const int dq = opaque(((qpos - 31) >> 4) - pos0 - 4 * h);
            const int oni = on ? 1 : 0;
#pragma unroll
            for (int tt = 0; tt < 2; ++tt)
#pragma unroll
                for (int i = 0; i < 16; ++i) {
                    const int rel = dq - (32 * tt + (i & 3) + 8 * (i >> 2));
                    float x = s[tt][i] * c1;
                    x = ((int)(rel >= 0) & oni) ? x : -1e30f;
                    s[tt][i] = x;
                    mx = fmaxf(mx, x);
                }
        } else {
            int dq = qpos - pos0 - 4 * h;
            dq = dq > 639 ? 639 : dq; dq = dq < -65 ? -65 : dq;
            dq = on ? dq : -65;
            const float* lp = lut + opaque(dq);
#pragma unroll
            for (int tt = 0; tt < 2; ++tt)
#pragma unroll
                for (int i = 0; i < 16; ++i) {
                    const float x = s[tt][i] * c1 + lp[128 - (32 * tt + (i & 3) + 8 * (i >> 2))];
                    s[tt][i] = x;
                    mx = fmaxf(mx, x);
                }
        }
        float mref;
        if (PASS != 2) {
            mx = fmaxf(mx, __shfl_xor(mx, 32));
            const float mnew = fmaxf(st.m, mx);
            alpha = fexp2(st.m - mnew);
            st.m = mnew;
            mref = mnew;
        } else mref = st.m;
#pragma unroll
        for (int tt = 0; tt < 2; ++tt)
#pragma unroll
            for (int i = 0; i < 16; ++i) {
                float pv = fexp2(s[tt][i] - mref);
                if (PASS == 2) pv *= rinv;
                s[tt][i] = pv; rs += pv;
            }
    }
    if (PASS != 2) {
        rs += __shfl_xor(rs, 32);
        st.l = st.l * alpha + rs;
    }
    f32x16 ia = zero16();
    if (PASS != 1) {
        if (PASS == 0) {
#pragma unroll
            for (int i = 0; i < 16; ++i) { st.o0[i] *= alpha; st.o1[i] *= alpha; }
        }
        const int G = lane >> 4, i16 = lane & 15, q = i16 >> 2, pp = i16 & 3;
        const char* vb = vbuf + (4 * (G >> 1) + q) * 128 + (16 * (G & 1) + 4 * pp) * 2;
#pragma unroll
        for (int tt = 0; tt < 2; ++tt)
#pragma unroll
            for (int ss = 0; ss < 2; ++ss) {
                f32x4 pa = {s[tt][8 * ss], s[tt][8 * ss + 1], s[tt][8 * ss + 2], s[tt][8 * ss + 3]};
                f32x4 pb2 = {s[tt][8 * ss + 4], s[tt][8 * ss + 5], s[tt][8 * ss + 6], s[tt][8 * ss + 7]};
                const bf16x8 pfrag = cvt8(pa, pb2);
                const char* vk = vb + (32 * tt + 16 * ss) * 128;
                if (PASS == 2) {
                    const int d = opaque((lane & 31) - h) - (8 * tt + 4 * ss);
                    const unsigned one2 = 0x3F803F80u, oneh = 0x3F800000u;
                    const uint4 ov = {d == 0 ? one2 : 0u, d == 0 ? one2 : (d == 1 ? oneh : 0u), d == 2 ? one2 : 0u, d == 2 ? one2 : (d == 3 ? oneh : 0u)};
                    ia = mfma32(__builtin_bit_cast(bf16x8, ov), pfrag, ia);
                }
                {
                    const s16x4 lo = tr_read(vk), hi = tr_read(vk + 8 * 128);
                    const bf16x8 va = __builtin_shufflevector(lo, hi, 0, 1, 2, 3, 4, 5, 6, 7);
                    st.o0 = mfma32(va, pfrag, st.o0);
                }
                {
                    const s16x4 lo = tr_read(vk + 64), hi = tr_read(vk + 8 * 128 + 64);
                    const bf16x8 va = __builtin_shufflevector(lo, hi, 0, 1, 2, 3, 4, 5, 6, 7);
                    st.o1 = mfma32(va, pfrag, st.o1);
                }
            }
    }
    if (PASS == 2) {
        float* dst = imp_row + (pos0 >> 2) + 4 * h;
        const bool wr = on && (lane & 3) == 0;
#pragma unroll
        for (int i = 0; i < 9; ++i) {
            float v = ia[i];
            v += __int_as_float(__builtin_amdgcn_update_dpp(0, __float_as_int(v), 0xB1, 0xf, 0xf, true));
            v += __int_as_float(__builtin_amdgcn_update_dpp(0, __float_as_int(v), 0x4E, 0xf, 0xf, true));
            if (wr && (i < 8 || h == 0)) dst[(i & 3) + 8 * (i >> 2)] += v;
        }
    }
}

struct OnFn {
    int kind; bool qvalid; unsigned long long lo, hi; int cur;
    DI bool operator()(int pos0) const {
        if (kind == 0) return qvalid;
        if (kind == 1) { const int blk = pos0 >> 8; return qvalid && (blk == cur || ((lo >> blk) & 1ull)); }
        const int j = pos0 >> 6;
        if (j >= 128) return qvalid;
        const unsigned long long x = j < 64 ? lo : hi;
        return qvalid && ((x >> (j & 63)) & 1ull) != 0ull;
    }
};

template <int MASK, int PASS>
DI void tile_step(Flash& st, const bf16x8 (&qf)[4], const char* kbuf, const char* vbuf, int pos0, int qpos, int qmin_w, int qmax_w,
                  const OnFn& onfn, const float* lut, float bfar, float* imp_row, float rinv) {
    const bool on = onfn(pos0);
    if (__any(on)) {
        bool farc;
        if (MASK == 0) farc = pos0 + 63 + 113 <= qmin_w;
        else if (MASK == 1) farc = (pos0 + 63 + 113 <= qmin_w) && (qmax_w - pos0 < 512);
        else farc = 16 * (pos0 + 63) + 31 <= qmin_w;
        if (farc) flash_tile<MASK, false, PASS>(st, qf, kbuf, vbuf, pos0, qpos, on, lut, bfar, imp_row, rinv);
        else flash_tile<MASK, true, PASS>(st, qf, kbuf, vbuf, pos0, qpos, on, lut, bfar, imp_row, rinv);
    }
}

template <int MASK, int PASS>
DI void run_tiles(Flash& st, const bf16x8 (&qf)[4], const TileSrc& src, const int* list, int n, char* kvbuf, int qpos,
                  int qmin_w, int qmax_w, const OnFn onfn, const float* lut, float bfar, float* imp_row, float rinv) {
    TileRegs R;
    if (n > 0) tile_issue(R, src, list[0]);
    for (int i = 0; i < n; ++i) {
        char* kbuf = kvbuf + (i & 1) * 16384; char* vbuf = kbuf + 8192;
        tile_store(R, kbuf, vbuf);
        __syncthreads();
        const int pos0 = list[i];
        if (i + 1 < n) tile_issue(R, src, list[i + 1]);
        tile_step<MASK, PASS>(st, qf, kbuf, vbuf, pos0, qpos, qmin_w, qmax_w, onfn, lut, bfar, imp_row, rinv);
    }
    __syncthreads();
}

struct BSrc { const u16* k; const u16* v; int maxpos; };
struct TileRegsB { bf16x8 k[2], v[2]; };
DI void tileb_issue(TileRegsB& R, const BSrc& s, int pos0) {
    const int t = threadIdx.x, c = t & 7;
    int r0 = pos0 + (t >> 3), r1 = r0 + 32;
    r0 = r0 < 0 ? 0 : (r0 > s.maxpos ? s.maxpos : r0);
    r1 = r1 < 0 ? 0 : (r1 > s.maxpos ? s.maxpos : r1);
    R.k[0] = *(const bf16x8*)(s.k + (size_t)r0 * 64 + c * 8); R.k[1] = *(const bf16x8*)(s.k + (size_t)r1 * 64 + c * 8);
    R.v[0] = *(const bf16x8*)(s.v + (size_t)r0 * 64 + c * 8); R.v[1] = *(const bf16x8*)(s.v + (size_t)r1 * 64 + c * 8);
}
DI void tileb_store(const TileRegsB& R, char* kbuf, char* vbuf) {
    const int t = threadIdx.x, key = t >> 3, c = t & 7, sw = (key >> 1) & 7;
    *(bf16x8*)(kbuf + key * 128 + ((c ^ sw) << 4)) = R.k[0];
    *(bf16x8*)(kbuf + 4096 + key * 128 + ((c ^ sw) << 4)) = R.k[1];
    *(bf16x8*)(vbuf + key * 128 + c * 16) = R.v[0];
    *(bf16x8*)(vbuf + 4096 + key * 128 + c * 16) = R.v[1];
}
template <int MASK, int PASS>
DI void run_tiles_b(Flash& st, const bf16x8 (&qf)[4], const BSrc& src, const int* list, int n, char* kvbuf, int qpos,
                    int qmin_w, int qmax_w, const OnFn onfn, const float* lut, float bfar, float* imp_row, float rinv) {
    TileRegsB RA, RB;
    if (n > 0) tileb_issue(RA, src, list[0]);
    if (n > 1) tileb_issue(RB, src, list[1]);
    for (int i = 0; i < n; i += 2) {
        {
            tileb_store(RA, kvbuf, kvbuf + 8192);
            __syncthreads();
            const int pos0 = list[i];
            if (i + 2 < n) tileb_issue(RA, src, list[i + 2]);
            tile_step<MASK, PASS>(st, qf, kvbuf, kvbuf + 8192, pos0, qpos, qmin_w, qmax_w, onfn, lut, bfar, imp_row, rinv);
        }
        if (i + 1 < n) {
            tileb_store(RB, kvbuf + 16384, kvbuf + 24576);
            __syncthreads();
            const int pos0 = list[i + 1];
            if (i + 3 < n) tileb_issue(RB, src, list[i + 3]);
            tile_step<MASK, PASS>(st, qf, kvbuf + 16384, kvbuf + 24576, pos0, qpos, qmin_w, qmax_w, onfn, lut, bfar, imp_row, rinv);
        }
    }
    __syncthreads();
}

constexpr int SM_KV = 0;
constexpr int SM_LIST = 32768;
constexpr int SM_LUT = 33792;
constexpr int SM_MISC = 46080;
constexpr int SM_SEL = 46336;
constexpr int SM_BIG = 46848;

DI void moba_item(const Params& p, char* sm, bool dec, int b, int hd, int qt) {
    const int t = opaque(threadIdx.x), lane = t & 63, w = t >> 6, c = lane & 31, h = lane >> 5;
    const int q0 = dec ? 8192 : qt * 128, nq = dec ? 4 : 128;
    const int qi = 32 * w + c, qic = qi < nq ? qi : nq - 1;
    const bool qvalid = qi < nq;
    const int qpos = q0 + qic;
    const size_t row = dec ? (size_t)NP + b * 4 + qic : (size_t)b * 8192 + qpos;
    const int cur = dec ? 32 : (q0 >> 8);
    int* list = (int*)(sm + SM_LIST);
    float* lut = (float*)(sm + SM_LUT);
    unsigned* misc = (unsigned*)(sm + SM_MISC);
    char* kmh = sm + SM_BIG; char* kml = sm + SM_BIG + 4096;

    bf16x8 qf[4];
    {
        const u16* qrow = (const u16*)(p.ws + WS_QM) + row * 512 + hd * 64;
#pragma unroll
        for (int ks = 0; ks < 4; ++ks) qf[ks] = *(const bf16x8*)(qrow + 16 * ks + 8 * h);
    }
    for (int i = t; i < LW; i += 256) lut[i] = ((const float*)(p.ws + WS_LUTG))[(size_t)hd * 2 * LW + i];
    {
        const int n = t >> 3, d0 = (t & 7) * 8;
        f32x4 a = {0.f, 0.f, 0.f, 0.f}, bq = a;
        if (n < cur) {
            const float* src = (const float*)(p.ws + WS_KMS) + ((size_t)b * 32 + n) * 512 + hd * 64 + d0;
            a = *(const f32x4*)src; bq = *(const f32x4*)(src + 4);
        }
        const bf16x8 hi = cvt8(a, bq);
        f32x4 ra, rb;
        ra.x = a.x - bf2f((u16)hi[0]); ra.y = a.y - bf2f((u16)hi[1]); ra.z = a.z - bf2f((u16)hi[2]); ra.w = a.w - bf2f((u16)hi[3]);
        rb.x = bq.x - bf2f((u16)hi[4]); rb.y = bq.y - bf2f((u16)hi[5]); rb.z = bq.z - bf2f((u16)hi[6]); rb.w = bq.w - bf2f((u16)hi[7]);
        *(bf16x8*)(kmh + n * 128 + d0 * 2) = hi;
        *(bf16x8*)(kml + n * 128 + d0 * 2) = cvt8(ra, rb);
    }
    if (t == 0) misc[0] = 0u;
    __syncthreads();
    f32x16 sc = zero16();
#pragma unroll
    for (int ks = 0; ks < 4; ++ks) {
        const bf16x8 ah = *(const bf16x8*)(kmh + c * 128 + (16 * ks + 8 * h) * 2);
        const bf16x8 al = *(const bf16x8*)(kml + c * 128 + (16 * ks + 8 * h) * 2);
        sc = mfma32(ah, qf[ks], sc);
        sc = mfma32(al, qf[ks], sc);
    }
    float v1 = -3e38f, v2 = -3e38f, v3 = -3e38f; int n1 = 99, n2 = 99, n3 = 99;
#pragma unroll
    for (int i = 0; i < 16; ++i) {
        const int n = crow(i, h);
        const float v = n < cur ? sc[i] : -3e38f;
        if (v > v1) { v3 = v2; n3 = n2; v2 = v1; n2 = n1; v1 = v; n1 = n; }
        else if (v > v2) { v3 = v2; n3 = n2; v2 = v; n2 = n; }
        else if (v > v3) { v3 = v; n3 = n; }
    }
    {
        const float pv[3] = {__shfl_xor(v1, 32), __shfl_xor(v2, 32), __shfl_xor(v3, 32)};
        const int pn[3] = {__shfl_xor(n1, 32), __shfl_xor(n2, 32), __shfl_xor(n3, 32)};
#pragma unroll
        for (int k = 0; k < 3; ++k) {
            const float v = pv[k]; const int n = pn[k];
            if (v > v1 || (v == v1 && n < n1)) { v3 = v2; n3 = n2; v2 = v1; n2 = n1; v1 = v; n1 = n; }
            else if (v > v2 || (v == v2 && n < n2)) { v3 = v2; n3 = n2; v2 = v; n2 = n; }
            else if (v > v3 || (v == v3 && n < n3)) { v3 = v; n3 = n; }
        }
    }
    unsigned sel = 0u;
    if (n1 < cur) sel |= 1u << n1;
    if (n2 < cur) sel |= 1u << n2;
    if (n3 < cur) sel |= 1u << n3;
    if (!qvalid) sel = 0u;
    {
        unsigned u = sel;
#pragma unroll
        for (int o = 1; o < 64; o <<= 1) u |= (unsigned)__shfl_xor((int)u, o);
        if (lane == 0) atomicOr(&misc[0], u);
    }
    __syncthreads();
    if (t == 0) {
        const unsigned U = misc[0];
        int n = 0;
        for (int blk = 0; blk <= cur; ++blk)
            if (blk == cur || ((U >> blk) & 1u))
                for (int sub = 0; sub < 4; ++sub) { const int pos0 = blk * 256 + sub * 64; if (pos0 <= q0 + nq - 1) list[n++] = pos0; }
        list[159] = n;
    }
    __syncthreads();
    const int ntile = list[159];
    TileSrc src;
    src.base = dec ? p.cache_m : p.out + O_MKP; src.pt = dec ? p.page_table : nullptr; src.base_new = p.out + O_MKS;
    src.P = 8192; src.ld = 1024; src.newbs = 4; src.kcol = hd * 64; src.vcol = 512 + hd * 64; src.b = b; src.posoff = 0;
    src.maxsrc = dec ? 8195 : 8191;
    Flash st; flash_init(st);
    const int qmin_w = q0 + (32 * w < nq ? 32 * w : nq - 1), qmax_w = q0 + (32 * w + 31 < nq ? 32 * w + 31 : nq - 1);
    const float bfar = lut[128 + 127];
    const OnFn onf{1, qvalid, (unsigned long long)sel, 0ull, cur};
    if (dec) run_tiles<0, 0>(st, qf, src, list, ntile, sm + SM_KV, qpos, qmin_w, qmax_w, onf, lut, bfar, nullptr, 0.f);
    else {
        BSrc bs{(const u16*)(p.ws + WS_KMB) + (size_t)(b * 8 + hd) * 8192 * 64, (const u16*)(p.ws + WS_VMB) + (size_t)(b * 8 + hd) * 8192 * 64, 8191};
        run_tiles_b<0, 0>(st, qf, bs, list, ntile, sm + SM_KV, qpos, qmin_w, qmax_w, onf, lut, bfar, nullptr, 0.f);
    }
    if (qvalid) {
        const float rl = 1.f / fmaxf(st.l, 1e-30f);
        const u16* zrow = (const u16*)(p.ws + WS_ZM) + row * 512 + hd * 64;
        u16* mrow = (u16*)(p.ws + WS_MIXED) + row * 1024 + hd * 64;
#pragma unroll
        for (int a = 0; a < 4; ++a) {
            const int d0 = 8 * a + 4 * h;
            const uint2 z0 = *(const uint2*)(zrow + d0), z1 = *(const uint2*)(zrow + 32 + d0);
            *(uint2*)(mrow + d0) = cvt4(st.o0[4 * a] * rl * bf2f(z0.x & 0xffff), st.o0[4 * a + 1] * rl * bf2f(z0.x >> 16),
                                        st.o0[4 * a + 2] * rl * bf2f(z0.y & 0xffff), st.o0[4 * a + 3] * rl * bf2f(z0.y >> 16));
            *(uint2*)(mrow + 32 + d0) = cvt4(st.o1[4 * a] * rl * bf2f(z1.x & 0xffff), st.o1[4 * a + 1] * rl * bf2f(z1.x >> 16),
                                             st.o1[4 * a + 2] * rl * bf2f(z1.y & 0xffff), st.o1[4 * a + 3] * rl * bf2f(z1.y >> 16));
        }
    }
    __syncthreads();
}

DI void moba_sel_item(const Params& p, char* sm, int b, int hd, int qt) {
    const int t = opaque(threadIdx.x), lane = t & 63, w = t >> 6, c = lane & 31, h = lane >> 5;
    const int q0 = qt * 128, q = q0 + 32 * w + c, cur = q0 >> 8;
    const size_t row = (size_t)b * 8192 + q;
    char* kmh = sm + SM_BIG; char* kml = sm + SM_BIG + 4096;
    unsigned* hist = (unsigned*)(sm + SM_MISC);
    unsigned* basep = (unsigned*)(sm + SM_MISC) + 32;
    unsigned* selg = (unsigned*)(p.ws + WS_SEL) + (size_t)(b * 8 + hd) * 8192;
    if (cur == 0) { if (h == 0) selg[q] = 0u; return; }
    bf16x8 qf[4];
    {
        const u16* qrow = (const u16*)(p.ws + WS_QM) + row * 512 + hd * 64;
#pragma unroll
        for (int ks = 0; ks < 4; ++ks) qf[ks] = *(const bf16x8*)(qrow + 16 * ks + 8 * h);
    }
    {
        const int n = t >> 3, d0 = (t & 7) * 8;
        f32x4 a = {0.f, 0.f, 0.f, 0.f}, bq = a;
        if (n < cur) {
            const float* src = (const float*)(p.ws + WS_KMP) + ((size_t)b * 32 + n) * 4 * 512 + hd * 64 + d0;
            a = (*(const f32x4*)src + *(const f32x4*)(src + 512)) + (*(const f32x4*)(src + 1024) + *(const f32x4*)(src + 1536));
            bq = (*(const f32x4*)(src + 4) + *(const f32x4*)(src + 516)) + (*(const f32x4*)(src + 1028) + *(const f32x4*)(src + 1540));
            a *= (1.f / 256.f); bq *= (1.f / 256.f);
        }
        const bf16x8 hi = cvt8(a, bq);
        f32x4 ra, rb;
        ra.x = a.x - bf2f((u16)hi[0]); ra.y = a.y - bf2f((u16)hi[1]); ra.z = a.z - bf2f((u16)hi[2]); ra.w = a.w - bf2f((u16)hi[3]);
        rb.x = bq.x - bf2f((u16)hi[4]); rb.y = bq.y - bf2f((u16)hi[5]); rb.z = bq.z - bf2f((u16)hi[6]); rb.w = bq.w - bf2f((u16)hi[7]);
        *(bf16x8*)(kmh + n * 128 + d0 * 2) = hi;
        *(bf16x8*)(kml + n * 128 + d0 * 2) = cvt8(ra, rb);
    }
    if (t < 32) hist[t] = 0u;
    __syncthreads();
    f32x16 sc = zero16();
#pragma unroll
    for (int ks = 0; ks < 4; ++ks) {
        const bf16x8 ah = *(const bf16x8*)(kmh + c * 128 + (16 * ks + 8 * h) * 2);
        const bf16x8 al = *(const bf16x8*)(kml + c * 128 + (16 * ks + 8 * h) * 2);
        sc = mfma32(ah, qf[ks], sc);
        sc = mfma32(al, qf[ks], sc);
    }
    float v1 = -3e38f, v2 = -3e38f, v3 = -3e38f; int n1 = 99, n2 = 99, n3 = 99;
#pragma unroll
    for (int i = 0; i < 16; ++i) {
        const int n = crow(i, h);
        const float v = n < cur ? sc[i] : -3e38f;
        if (v > v1) { v3 = v2; n3 = n2; v2 = v1; n2 = n1; v1 = v; n1 = n; }
        else if (v > v2) { v3 = v2; n3 = n2; v2 = v; n2 = n; }
        else if (v > v3) { v3 = v; n3 = n; }
    }
    {
        const float pv0 = __shfl_xor(v1, 32), pv1 = __shfl_xor(v2, 32), pv2 = __shfl_xor(v3, 32);
        const int pn0 = __shfl_xor(n1, 32), pn1 = __shfl_xor(n2, 32), pn2 = __shfl_xor(n3, 32);
#pragma unroll
        for (int k = 0; k < 3; ++k) {
            const float v = k == 0 ? pv0 : (k == 1 ? pv1 : pv2); const int n = k == 0 ? pn0 : (k == 1 ? pn1 : pn2);
            if (v > v1 || (v == v1 && n < n1)) { v3 = v2; n3 = n2; v2 = v1; n2 = n1; v1 = v; n1 = n; }
            else if (v > v2 || (v == v2 && n < n2)) { v3 = v2; n3 = n2; v2 = v; n2 = n; }
            else if (v > v3 || (v == v3 && n < n3)) { v3 = v; n3 = n; }
        }
    }
    unsigned sel = 0u;
    if (n1 < cur) sel |= 1u << n1;
    if (n2 < cur) sel |= 1u << n2;
    if (n3 < cur) sel |= 1u << n3;
    unsigned r1 = 0u, r2 = 0u, r3 = 0u;
    if (h == 0) {
        selg[q] = sel;
        if (n1 < cur) r1 = atomicAdd(&hist[n1], 1u);
        if (n2 < cur) r2 = atomicAdd(&hist[n2], 1u);
        if (n3 < cur) r3 = atomicAdd(&hist[n3], 1u);
    }
    __syncthreads();
    unsigned* mcnt = (unsigned*)(p.ws + WS_MCNT) + (b * 8 + hd) * 32;
    if (t < 32) basep[t] = hist[t] ? __hip_atomic_fetch_add(&mcnt[t], hist[t], __ATOMIC_RELAXED, __HIP_MEMORY_SCOPE_AGENT) : 0u;
    __syncthreads();
    if (h == 0) {
        u16* lst = (u16*)(p.ws + WS_LIST) + (size_t)(b * 8 + hd) * 32 * 8192;
        if (n1 < cur) lst[(size_t)n1 * 8192 + basep[n1] + r1] = (u16)q;
        if (n2 < cur) lst[(size_t)n2 * 8192 + basep[n2] + r2] = (u16)q;
        if (n3 < cur) lst[(size_t)n3 * 8192 + basep[n3] + r3] = (u16)q;
    }
    __syncthreads();
}

DI void moba_gather_item(const Params& p, char* sm, int b, int hd, int n, int chunk, int cnt) {
    const int t = opaque(threadIdx.x), lane = t & 63, w = t >> 6, c = lane & 31, h = lane >> 5;
    int* list = (int*)(sm + SM_LIST);
    float* lut = (float*)(sm + SM_LUT);
    const int e = chunk * 128 + 32 * w + c;
    const bool qvalid = e < cnt;
    const u16* lst = (const u16*)(p.ws + WS_LIST) + ((size_t)(b * 8 + hd) * 32 + n) * 8192;
    const int q = lst[qvalid ? e : cnt - 1];
    const size_t row = (size_t)b * 8192 + q;
    bf16x8 qf[4];
    {
        const u16* qrow = (const u16*)(p.ws + WS_QM) + row * 512 + hd * 64;
#pragma unroll
        for (int ks = 0; ks < 4; ++ks) qf[ks] = *(const bf16x8*)(qrow + 16 * ks + 8 * h);
    }
    for (int i = t; i < LW; i += 256) lut[i] = ((const float*)(p.ws + WS_LUTG))[(size_t)hd * 2 * LW + i];
    if (t < 4) list[t] = n * 256 + t * 64;
    __syncthreads();
    int qmin_w = qvalid ? q : 0x7fffffff;
#pragma unroll
    for (int o = 1; o < 64; o <<= 1) { const int x = __shfl_xor(qmin_w, o); qmin_w = x < qmin_w ? x : qmin_w; }
    const float bfar = lut[128 + 127];
    Flash st; flash_init(st);
    const OnFn onf{0, qvalid, 0ull, 0ull, 0};
    const BSrc bs{(const u16*)(p.ws + WS_KMB) + (size_t)(b * 8 + hd) * 8192 * 64, (const u16*)(p.ws + WS_VMB) + (size_t)(b * 8 + hd) * 8192 * 64, 8191};
    run_tiles_b<0, 0>(st, qf, bs, list, 4, sm + SM_KV, q, qmin_w, 0, onf, lut, bfar, nullptr, 0.f);
    if (qvalid) {
        const unsigned sel = ((const unsigned*)(p.ws + WS_SEL))[(size_t)(b * 8 + hd) * 8192 + q];
        const int slot = __popc(sel & ((1u << n) - 1u));
        float* pp = (float*)(p.ws + WS_PART) + (((size_t)(b * 8 + hd) * 8192 + q) * 3 + slot) * 68;
        if (h == 0) { pp[0] = st.m; pp[1] = st.l; }
#pragma unroll
        for (int a = 0; a < 4; ++a) {
            f32x4 v0 = {st.o0[4 * a], st.o0[4 * a + 1], st.o0[4 * a + 2], st.o0[4 * a + 3]};
            f32x4 v1 = {st.o1[4 * a], st.o1[4 * a + 1], st.o1[4 * a + 2], st.o1[4 * a + 3]};
            *(f32x4*)(pp + 4 + 8 * a + 4 * h) = v0; *(f32x4*)(pp + 4 + 32 + 8 * a + 4 * h) = v1;
        }
    }
    __syncthreads();
}

DI void moba_own_item(const Params& p, char* sm, int b, int hd, int qt) {
    const int t = opaque(threadIdx.x), lane = t & 63, w = t >> 6, c = lane & 31, h = lane >> 5;
    int* list = (int*)(sm + SM_LIST);
    float* lut = (float*)(sm + SM_LUT);
    const int q0 = qt * 128, q = q0 + 32 * w + c, cur = q0 >> 8;
    const size_t row = (size_t)b * 8192 + q;
    bf16x8 qf[4];
    {
        const u16* qrow = (const u16*)(p.ws + WS_QM) + row * 512 + hd * 64;
#pragma unroll
        for (int ks = 0; ks < 4; ++ks) qf[ks] = *(const bf16x8*)(qrow + 16 * ks + 8 * h);
    }
    for (int i = t; i < LW; i += 256) lut[i] = ((const float*)(p.ws + WS_LUTG))[(size_t)hd * 2 * LW + i];
    const int ntile = ((q0 + 127) >> 6) - cur * 4 + 1;
    if (t < 4) list[t] = cur * 256 + t * 64;
    __syncthreads();
    const float bfar = lut[128 + 127];
    Flash st; flash_init(st);
    const OnFn onf{0, true, 0ull, 0ull, 0};
    const BSrc bs{(const u16*)(p.ws + WS_KMB) + (size_t)(b * 8 + hd) * 8192 * 64, (const u16*)(p.ws + WS_VMB) + (size_t)(b * 8 + hd) * 8192 * 64, 8191};
    run_tiles_b<0, 0>(st, qf, bs, list, ntile, sm + SM_KV, q, q0 + 32 * w, 0, onf, lut, bfar, nullptr, 0.f);
    {
        const unsigned sel = ((const unsigned*)(p.ws + WS_SEL))[(size_t)(b * 8 + hd) * 8192 + q];
        const int ns = __popc(sel);
        const float* pp = (const float*)(p.ws + WS_PART) + ((size_t)(b * 8 + hd) * 8192 + q) * 3 * 68;
        const float pm0 = ns > 0 ? pp[0] : -1e20f, pm1 = ns > 1 ? pp[68] : -1e20f, pm2 = ns > 2 ? pp[136] : -1e20f;
        const float pl0 = pp[1], pl1 = pp[69], pl2 = pp[137];
        const float M = fmaxf(fmaxf(st.m, pm0), fmaxf(pm1, pm2));
        const float f = fexp2(st.m - M), f0 = ns > 0 ? fexp2(pm0 - M) : 0.f, f1 = ns > 1 ? fexp2(pm1 - M) : 0.f, f2 = ns > 2 ? fexp2(pm2 - M) : 0.f;
        const float rl = 1.f / fmaxf(st.l * f + (ns > 0 ? pl0 * f0 : 0.f) + (ns > 1 ? pl1 * f1 : 0.f) + (ns > 2 ? pl2 * f2 : 0.f), 1e-30f);
        const u16* zrow = (const u16*)(p.ws + WS_ZM) + row * 512 + hd * 64;
        u16* mrow = (u16*)(p.ws + WS_MIXED) + row * 1024 + hd * 64;
        uint2 r0[4], r1[4];
#pragma unroll
        for (int a = 0; a < 4; ++a) {
            const int d0 = 8 * a + 4 * h;
            const f32x4 zz = {0.f, 0.f, 0.f, 0.f};
            const f32x4 a0 = *(const f32x4*)(pp + 4 + d0), b0 = *(const f32x4*)(pp + 36 + d0);
            const f32x4 a1 = *(const f32x4*)(pp + 68 + 4 + d0), b1 = *(const f32x4*)(pp + 68 + 36 + d0);
            const f32x4 a2 = *(const f32x4*)(pp + 136 + 4 + d0), b2 = *(const f32x4*)(pp + 136 + 36 + d0);
            f32x4 v0 = {st.o0[4 * a] * f, st.o0[4 * a + 1] * f, st.o0[4 * a + 2] * f, st.o0[4 * a + 3] * f};
            f32x4 v1 = {st.o1[4 * a] * f, st.o1[4 * a + 1] * f, st.o1[4 * a + 2] * f, st.o1[4 * a + 3] * f};
            v0 += ns > 0 ? f0 * a0 : zz; v1 += ns > 0 ? f0 * b0 : zz;
            v0 += ns > 1 ? f1 * a1 : zz; v1 += ns > 1 ? f1 * b1 : zz;
            v0 += ns > 2 ? f2 * a2 : zz; v1 += ns > 2 ? f2 * b2 : zz;
            const uint2 z0 = *(const uint2*)(zrow + d0), z1 = *(const uint2*)(zrow + 32 + d0);
            r0[a] = cvt4(v0.x * rl * bf2f(z0.x & 0xffff), v0.y * rl * bf2f(z0.x >> 16), v0.z * rl * bf2f(z0.y & 0xffff), v0.w * rl * bf2f(z0.y >> 16));
            r1[a] = cvt4(v1.x * rl * bf2f(z1.x & 0xffff), v1.y * rl * bf2f(z1.x >> 16), v1.z * rl * bf2f(z1.y & 0xffff), v1.w * rl * bf2f(z1.y >> 16));
        }
#pragma unroll
        for (int a = 0; a < 4; ++a) { *(uint2*)(mrow + 8 * a + 4 * h) = r0[a]; *(uint2*)(mrow + 32 + 8 * a + 4 * h) = r1[a]; }
    }
    __syncthreads();
}

DI void nsa_item(const Params& p, char* sm, bool dec, int b, int kvh, int q32) {
    const int t = opaque(threadIdx.x), lane = t & 63, w = t >> 6, c = lane & 31, h = lane >> 5;
    const int g = c & 3;
    const int q0 = dec ? 8192 : q32 * 32, nq = dec ? 4 : 32;
    const int qi = 8 * w + (c >> 2), qic = qi < nq ? qi : nq - 1;
    const bool qvalid = qi < nq;
    const int qpos = q0 + qic;
    const size_t row = dec ? (size_t)NP + b * 4 + qic : (size_t)b * 8192 + qpos;
    const int head = kvh * 4 + g;
    const int cur = dec ? 128 : (q0 >> 6);
    int* list = (int*)(sm + SM_LIST);
    float* lutall = (float*)(sm + SM_LUT);
    const float* lut = lutall + g * LW;
    unsigned* misc = (unsigned*)(sm + SM_MISC);
    unsigned* selw = (unsigned*)(sm + SM_SEL);
    float* imp = (float*)(sm + SM_BIG);
    const int qmin_w = q0 + (8 * w < nq ? 8 * w : nq - 1), qmax_w = q0 + (8 * w + 7 < nq ? 8 * w + 7 : nq - 1);

    bf16x8 qf[4];
    {
        const u16* qrow = (const u16*)(p.ws + WS_QN) + row * 512 + head * 64;
#pragma unroll
        for (int ks = 0; ks < 4; ++ks) qf[ks] = *(const bf16x8*)(qrow + 16 * ks + 8 * h);
    }
    for (int i = t; i < 4 * LW; i += 256) lutall[i] = ((const float*)(p.ws + WS_LUTG))[(size_t)(8 + kvh * 4 + i / LW) * 2 * LW + (i % LW)];
    for (int i = t; i < 32 * IMPLD; i += 256) imp[i] = 0.f;
    const int ntok = dec ? 511 : (q0 / 16 + 1);
    if (t == 0) {
        int n = 0;
#pragma unroll 1
        for (int pos0 = 0; pos0 < ntok; pos0 += 64) list[n++] = pos0;
        list[159] = n;
        misc[0] = misc[1] = misc[2] = misc[3] = 0u;
    }
    __syncthreads();
    const float bfar = lut[128 + 127];
    const float* gt = (const float*)(p.ws + WS_GATES) + row * 24 + head * 3;
    const float g0 = gt[0], g1 = gt[1], g2 = gt[2];
    float* trow = (float*)(p.ws + WS_XNEW) + row * 512 + head * 64 + 4 * h;
    {
        const size_t cb = (size_t)((dec ? 2 + b : b) * 2 + kvh) * 512 * 64;
        const BSrc bs{(const u16*)(p.ws + WS_CKB) + cb, (const u16*)(p.ws + WS_CVB) + cb, 510};
        const int ntile = list[159];
        Flash st; flash_init(st);
        const OnFn onf{0, qvalid, 0ull, 0ull, 0};
        run_tiles_b<2, 1>(st, qf, bs, list, ntile, sm + SM_KV, qpos, qmin_w, qmax_w, onf, lut, 0.f, nullptr, 0.f);
        const float rinv = 1.f / fmaxf(st.l, 1e-30f);
        run_tiles_b<2, 2>(st, qf, bs, list, ntile, sm + SM_KV, qpos, qmin_w, qmax_w, onf, lut, 0.f, imp + qic * IMPLD, rinv);
        if (qvalid)
#pragma unroll
        for (int a = 0; a < 4; ++a) {
            f32x4 v0 = {g0 * st.o0[4 * a], g0 * st.o0[4 * a + 1], g0 * st.o0[4 * a + 2], g0 * st.o0[4 * a + 3]};
            f32x4 v1 = {g0 * st.o1[4 * a], g0 * st.o1[4 * a + 1], g0 * st.o1[4 * a + 2], g0 * st.o1[4 * a + 3]};
            *(f32x4*)(trow + 8 * a) = v0; *(f32x4*)(trow + 32 + 8 * a) = v1;
        }
    }
    {
        const int qc = t >> 3, part = t & 7, j0 = part * 16;
        unsigned bits = 0u;
        if (cur + 1 <= 16) {
#pragma unroll
            for (int jj = 0; jj < 16; ++jj) if (j0 + jj <= cur) bits |= 1u << jj;
        } else {
            const int K = 13;
            unsigned long long v[16]; int cnt[16];
#pragma unroll
            for (int jj = 0; jj < 16; ++jj) { v[jj] = ((unsigned long long)__float_as_uint(imp[qc * IMPLD + j0 + jj]) << 32) | (unsigned)(255 - (j0 + jj)); cnt[jj] = 0; }
            for (int k = 1; k <= cur - 2; ++k) {
                const unsigned long long x = ((unsigned long long)__float_as_uint(imp[qc * IMPLD + k]) << 32) | (unsigned)(255 - k);
#pragma unroll
                for (int jj = 0; jj < 16; ++jj) cnt[jj] += x > v[jj] ? 1 : 0;
            }
#pragma unroll
            for (int jj = 0; jj < 16; ++jj) {
                const int j = j0 + jj;
                const bool forced = (j == 0) || (j == cur) || (j == cur - 1);
                if (j <= cur && (forced || cnt[jj] < K)) bits |= 1u << jj;
            }
        }
        ((u16*)selw)[qc * 8 + part] = (u16)bits;
    }
    __syncthreads();
    unsigned s0 = selw[qic * 4 + 0], s1 = selw[qic * 4 + 1], s2 = selw[qic * 4 + 2], s3 = selw[qic * 4 + 3];
    if (!qvalid) { s0 = s1 = s2 = s3 = 0u; }
    {
        unsigned u0 = s0, u1 = s1, u2 = s2, u3 = s3;
#pragma unroll
        for (int o = 1; o < 64; o <<= 1) {
            u0 |= (unsigned)__shfl_xor((int)u0, o); u1 |= (unsigned)__shfl_xor((int)u1, o);
            u2 |= (unsigned)__shfl_xor((int)u2, o); u3 |= (unsigned)__shfl_xor((int)u3, o);
        }
        if (lane == 0) { atomicOr(&misc[0], u0); atomicOr(&misc[1], u1); atomicOr(&misc[2], u2); atomicOr(&misc[3], u3); }
    }
    __syncthreads();
    if (t < 128) {
        const unsigned u0 = misc[0], u1 = misc[1], u2 = misc[2], u3 = misc[3];
        const int wq = t >> 5;
        const unsigned wv = wq == 0 ? u0 : (wq == 1 ? u1 : (wq == 2 ? u2 : u3));
        const int before = (wq > 0 ? __popc(u0) : 0) + (wq > 1 ? __popc(u1) : 0) + (wq > 2 ? __popc(u2) : 0);
        if ((wv >> (t & 31)) & 1u) list[before + __popc(wv & ((1u << (t & 31)) - 1u))] = t * 64;
        if (t == 0) {
            int n = __popc(u0) + __popc(u1) + __popc(u2) + __popc(u3);
            if (cur == 128) list[n++] = 128 * 64;
            list[159] = n;
        }
    }
    __syncthreads();
    {
        const int ntile = list[159];
        Flash st; flash_init(st);
        const OnFn onf{2, qvalid, (unsigned long long)s0 | ((unsigned long long)s1 << 32), (unsigned long long)s2 | ((unsigned long long)s3 << 32), cur};
        if (dec) {
            TileSrc src;
            src.base = p.cache_n; src.pt = p.page_table; src.base_new = p.out + O_NKS;
            src.P = 8192; src.ld = 512; src.newbs = 4; src.kcol = 256 + kvh * 64; src.vcol = 384 + kvh * 64; src.b = b; src.posoff = 0;
            src.maxsrc = 8195;
            run_tiles<0, 0>(st, qf, src, list, ntile, sm + SM_KV, qpos, qmin_w, qmax_w, onf, lut, bfar, nullptr, 0.f);
        } else {
            const size_t hb = (size_t)(b * 2 + kvh) * 8192 * 64;
            const BSrc bs{(const u16*)(p.ws + WS_KSB) + hb, (const u16*)(p.ws + WS_VSB) + hb, 8191};
            run_tiles_b<0, 0>(st, qf, bs, list, ntile, sm + SM_KV, qpos, qmin_w, qmax_w, onf, lut, bfar, nullptr, 0.f);
        }
        const float rl = g1 / fmaxf(st.l, 1e-30f);
        if (qvalid)
#pragma unroll
        for (int a = 0; a < 4; ++a) {
            f32x4 v0 = *(const f32x4*)(trow + 8 * a), v1 = *(const f32x4*)(trow + 32 + 8 * a);
            v0.x += rl * st.o0[4 * a]; v0.y += rl * st.o0[4 * a + 1]; v0.z += rl * st.o0[4 * a + 2]; v0.w += rl * st.o0[4 * a + 3];
            v1.x += rl * st.o1[4 * a]; v1.y += rl * st.o1[4 * a + 1]; v1.z += rl * st.o1[4 * a + 2]; v1.w += rl * st.o1[4 * a + 3];
            *(f32x4*)(trow + 8 * a) = v0; *(f32x4*)(trow + 32 + 8 * a) = v1;
        }
    }
    {
        for (int i = t; i < 4 * LW; i += 256) lutall[i] = ((const float*)(p.ws + WS_LUTG))[(size_t)(8 + kvh * 4 + i / LW) * 2 * LW + LW + (i % LW)];
        if (t == 0) {
            int n = 0;
            int lo = q0 - 511; lo = lo < 0 ? 0 : lo; lo &= ~63;
#pragma unroll 1
            for (int pos0 = lo; pos0 <= q0 + nq - 1; pos0 += 64) list[n++] = pos0;
            list[159] = n;
        }
        __syncthreads();
        const int ntile = list[159];
        Flash st; flash_init(st);
        const OnFn onf{0, qvalid, 0ull, 0ull, 0};
        if (dec) {
            TileSrc src;
            src.base = p.win_state; src.pt = nullptr; src.base_new = p.out + O_WS + (size_t)508 * 256;
            src.P = 512; src.ld = 256; src.newbs = 512; src.posoff = 7680; src.maxsrc = 515;
            src.kcol = kvh * 64; src.vcol = 128 + kvh * 64; src.b = b;
            run_tiles<1, 0>(st, qf, src, list, ntile, sm + SM_KV, qpos, qmin_w, qmax_w, onf, lut, bfar, nullptr, 0.f);
        } else {
            const size_t hb = (size_t)(b * 2 + kvh) * 8192 * 64;
            const BSrc bs{(const u16*)(p.ws + WS_KWB) + hb, (const u16*)(p.ws + WS_VWB) + hb, 8191};
            run_tiles_b<1, 0>(st, qf, bs, list, ntile, sm + SM_KV, qpos, qmin_w, qmax_w, onf, lut, bfar, nullptr, 0.f);
        }
        const float rl = g2 / fmaxf(st.l, 1e-30f);
        if (qvalid) {
            const u16* zrow = (const u16*)(p.ws + WS_ZN) + row * 512 + head * 64;
            u16* mrow = (u16*)(p.ws + WS_MIXED) + row * 1024 + 512 + head * 64;
#pragma unroll
            for (int a = 0; a < 4; ++a) {
                const int d0 = 8 * a + 4 * h;
                const f32x4 v0 = *(const f32x4*)(trow + 8 * a), v1 = *(const f32x4*)(trow + 32 + 8 * a);
                const uint2 z0 = *(const uint2*)(zrow + d0), z1 = *(const uint2*)(zrow + 32 + d0);
                *(uint2*)(mrow + d0) = cvt4((v0.x + rl * st.o0[4 * a]) * bf2f(z0.x & 0xffff), (v0.y + rl * st.o0[4 * a + 1]) * bf2f(z0.x >> 16),
                                            (v0.z + rl * st.o0[4 * a + 2]) * bf2f(z0.y & 0xffff), (v0.w + rl * st.o0[4 * a + 3]) * bf2f(z0.y >> 16));
                *(uint2*)(mrow + 32 + d0) = cvt4((v1.x + rl * st.o1[4 * a]) * bf2f(z1.x & 0xffff), (v1.y + rl * st.o1[4 * a + 1]) * bf2f(z1.x >> 16),
                                                 (v1.z + rl * st.o1[4 * a + 2]) * bf2f(z1.y & 0xffff), (v1.w + rl * st.o1[4 * a + 3]) * bf2f(z1.y >> 16));
            }
        }
    }
    __syncthreads();
}

constexpr int P2_CMP = 512, P2_G1 = 129 * 31;
DI void phase2(const Params& p, char* sm, int mode = 0) {
    if (mode != 2)
        for (int it = blockIdx.x; it < P2_CMP; it += gridDim.x) compress_item(p, true, it >> 8, (it >> 3) & 31, it & 7, sm);
    if (mode != 1) {
        const int x = blockIdx.x & 7, ntn = x < 7 ? 4 : 3, nb = gridDim.x >> 3, j = blockIdx.x >> 3;
        const int lim = 128 * ntn, nown = j < lim ? (lim - j + nb - 1) / nb : 0;
        auto tile_at = [&](int idx, int& tm, int& tn) -> bool {
            if (idx < nown) { const int s2 = j + idx * nb; tm = s2 / ntn; tn = 4 * x + s2 % ntn; return true; }
            const int e = j + (idx - nown) * nb;
            tm = 128; tn = e;
            return x == 7 && e < 31;
        };
        GemmRegs<ALoadBf16> G; bool pre = false;
        int tm = 0, tn = 0;
        bool have = tile_at(0, tm, tn);
        for (int idx = 0; have; ++idx) {
            int tmn = 0, tnn = 0;
            const bool hn = tile_at(idx + 1, tmn, tnn);
            gemm1_tile(p, G, pre, tm, tn, hn, tmn, tnn, sm);
            pre = hn; have = hn; tm = tmn; tn = tnn;
        }
    }
}
DI void phase3b(const Params& p, char* sm) {
    for (int it = blockIdx.x; it < 1024; it += gridDim.x) moba_sel_item(p, sm, (it >> 3) & 1, it & 7, 63 - (it >> 4));
}
constexpr int P4_CMPP = 32, P4_NSAS = 64, P4_MOBAS = 256, P4_NSAP = 1024, P4_PRE = 192;
constexpr int SM_PFX = 63744;
constexpr size_t WS_FLAG = WS_CTR + 12288;
DI void phase4(const Params& p, char* sm, int cidx = 0) {
    unsigned* ctr = (unsigned*)(p.ws + WS_CTR) + cidx * 64;
    unsigned* flag = (unsigned*)(p.ws + WS_FLAG);
    int* slot = (int*)(sm + LDS_BYTES - 16);
    int* pfx = (int*)(sm + SM_PFX);
    const unsigned* mcnt = (const unsigned*)(p.ws + WS_MCNT);
    for (int it = blockIdx.x; it < P4_CMPP; it += gridDim.x) {
        compress_item(p, false, it >> 4, (it >> 3) & 1, it & 7, sm);
        asm volatile("s_waitcnt vmcnt(0)" ::: "memory");
        __syncthreads();
        if (threadIdx.x == 0) {
            __builtin_amdgcn_fence(__ATOMIC_RELEASE, "agent");
            asm volatile("s_waitcnt vmcnt(0)" ::: "memory");
            (void)xb_add(&flag[64 * ((it >> 3) & 1)], 1u);
        }
    }
    for (int i = threadIdx.x; i < 512; i += NTHREADS) pfx[i] = i < 496 ? (int)((mcnt[i + (i / 31) + 0] + 127u) >> 7) : 0;
    __syncthreads();
    if (threadIdx.x < 64) {
        const int l = threadIdx.x;
        int c[8], tot = 0;
#pragma unroll
        for (int j = 0; j < 8; ++j) { c[j] = pfx[8 * l + j]; tot += c[j]; }
        int inc = tot;
#pragma unroll
        for (int o = 1; o < 64; o <<= 1) { const int y = __shfl_up(inc, o); if (l >= o) inc += y; }
        int base = inc - tot;
#pragma unroll
        for (int j = 0; j < 8; ++j) { if (8 * l + j < 496) pfx[8 * l + j] = base; base += c[j]; }
        if (l == 63) pfx[496] = inc;
    }
    __syncthreads();
    const int G = pfx[496];
    const int pre = G < P4_PRE ? G : P4_PRE;
    const int Gr = G - pre;
    const int nint = Gr < P4_NSAP ? Gr : P4_NSAP;
    const int total = P4_NSAS + P4_MOBAS + P4_NSAP + G;
    int seen = 0;
    for (;;) {
        if (threadIdx.x == 0) *slot = (int)__hip_atomic_fetch_add(ctr, 1u, __ATOMIC_RELAXED, __HIP_MEMORY_SCOPE_AGENT);
        __syncthreads();
        const int it = *slot;
        __syncthreads();
        if (it >= total) break;
        int r = it;
        if (r < P4_NSAS) { nsa_item(p, sm, true, r >> 1, r & 1, 0); continue; }
        r -= P4_NSAS;
        if (r < P4_MOBAS) { moba_item(p, sm, true, r >> 3, r & 7, 0); continue; }
        r -= P4_MOBAS;
        int kn = -1, kg = -1;
        if (r < pre) kg = r;
        else {
            r -= pre;
            if (r < 2 * nint) { if (r & 1) kg = pre + (r >> 1); else kn = r >> 1; }
            else if (Gr > P4_NSAP) kg = pre + r - nint; else kn = r - nint;
        }
        if (kn >= 0) {
            const int b = (kn >> 1) & 1;
            if (!((seen >> b) & 1)) {
                if (threadIdx.x == 0) {
                    unsigned sp = 0u;
                    while (xb_ld(&flag[64 * b]) < 16u) { __builtin_amdgcn_s_sleep(2); if (++sp > XB_SPIN_CAP) break; }
                    __builtin_amdgcn_fence(__ATOMIC_ACQUIRE, "agent");
                    asm volatile("s_waitcnt vmcnt(0)" ::: "memory");
                }
                __syncthreads();
                seen |= 1 << b;
            }
            nsa_item(p, sm, false, b, kn & 1, 255 - (kn >> 2));
            continue;
        }
        int lo = 0, hi = 496;
        while (hi - lo > 1) { const int mid = (lo + hi) >> 1; if (pfx[mid] <= kg) lo = mid; else hi = mid; }
        const int bh = lo / 31, n = lo - bh * 31;
        moba_gather_item(p, sm, bh >> 3, bh & 7, n, kg - pfx[lo], (int)mcnt[bh * 32 + n]);
    }
}
DI void phase4c(const Params& p, char* sm, int cidx = 0) {
    unsigned* ctr = (unsigned*)(p.ws + WS_CTR) + 128 + cidx * 64;
    int* slot = (int*)(sm + LDS_BYTES - 16);
    for (;;) {
        if (threadIdx.x == 0) *slot = (int)__hip_atomic_fetch_add(ctr, 1u, __ATOMIC_RELAXED, __HIP_MEMORY_SCOPE_AGENT);
        __syncthreads();
        const int it = *slot;
        __syncthreads();
        if (it >= 1024 + 8) break;
        if (it < 8) { GemmRegs<ALoadBf16> G; gemm2_tile<true>(p, G, false, opaque_s(128), it, false, 0, 0, sm); continue; }
        const int r = it - 8;
        moba_own_item(p, sm, (r >> 3) & 1, r & 7, 63 - (r >> 4));
    }
}
DI void phase5(const Params& p, char* sm) {
    const int x = blockIdx.x & 7, nb = gridDim.x >> 3;
    GemmRegs<ALoadBf16> G; bool pre = false;
    for (int s2 = blockIdx.x >> 3; s2 < 128; s2 += nb) {
        const int s2n = s2 + nb; const bool hn = s2n < 128;
        gemm2_tile<false>(p, G, pre, s2, x, hn, s2n, x, sm);
        pre = hn;
    }
}
DI void phase6(const Params& p, char* sm) {
    const int tt_ = opaque(threadIdx.x), lane = tt_ & 63, w = tt_ >> 6;
    const float* xnew = (const float*)(p.ws + WS_XNEW);
    for (int row = NP + blockIdx.x * 4 + w; row < NT; row += gridDim.x * 4) {
        const float* xr = xnew + (size_t)row * 1024;
        float* yr = row < NP ? p.out + O_YP + (size_t)row * 1024 : p.out + O_YS + (size_t)(row - NP) * 1024;
        f32x4 v[4]; float ss = 0.f;
#pragma unroll
        for (int j = 0; j < 4; ++j) { v[j] = *(const f32x4*)(xr + lane * 4 + 256 * j); ss += v[j].x * v[j].x + v[j].y * v[j].y + v[j].z * v[j].z + v[j].w * v[j].w; }
        ss = wave_sum(ss);
        const float inv = rsqrtf(ss * (1.f / 1024.f) + 1e-6f);
#pragma unroll
        for (int j = 0; j < 4; ++j) {
            const f32x4 g = *(const f32x4*)(p.final_gain + lane * 4 + 256 * j);
            f32x4 o; o.x = v[j].x * inv * g.x; o.y = v[j].y * inv * g.y; o.z = v[j].z * inv * g.z; o.w = v[j].w * inv * g.w;
            *(f32x4*)(yr + lane * 4 + 256 * j) = o;
        }
    }
}

template <int PH>
__global__ void __launch_bounds__(NTHREADS, 2) phase_kernel(Params p) {
    extern __shared__ __attribute__((aligned(16))) char sm[];
    if (PH == 0) phase0(p, sm);
    else if (PH == 1) phase1(p, sm);
    else if (PH == 2) phase2(p, sm);
    else if (PH == 4) phase4(p, sm);
    else if (PH == 5) phase5(p, sm);
    else phase6(p, sm);
}

__global__ void __launch_bounds__(NTHREADS, 2) mega_kernel(Params p) {
    extern __shared__ __attribute__((aligned(16))) char sm[];
    uint4* xbw = (uint4*)(sm + LDS_BYTES - 32);
    if (threadIdx.x == 0) *xbw = make_uint4(0u, 0u, 0u, 0u);
    __syncthreads();
    XcdBarrier bar = xcd_barrier_post((unsigned*)(p.ws + WS_BAR), (volatile LAS unsigned*)(LAS char*)(sm + LDS_BYTES - 32));
    phase0(p, sm); xcd_barrier(bar);
    if (REP == 0) { phase0(p, sm); xcd_barrier(bar); }
    if (REP >= 1000 && REP < 1016) { phase0(p, sm, REP - 1000); xcd_barrier(bar); }
    phase1(p, sm); xcd_barrier(bar);
    if (REP == 1) { phase1(p, sm); xcd_barrier(bar); }
    phase2(p, sm); xcd_barrier(bar);
    if (REP == 2) { phase2(p, sm); xcd_barrier(bar); }
    if (REP == 20) { phase2(p, sm, 1); xcd_barrier(bar); }
    if (REP == 21) { phase2(p, sm, 2); xcd_barrier(bar); }
    phase3b(p, sm); xcd_barrier(bar);
    phase4(p, sm); xcd_barrier(bar);
    if (REP == 4) { phase4(p, sm, 1); xcd_barrier(bar); }
    phase4c(p, sm); xcd_barrier(bar);
    if (REP == 7) { phase4c(p, sm, 1); xcd_barrier(bar); }
    phase5(p, sm);
    phase6(p, sm);
}

extern "C" void kernel_launch(void* const* d_in, const int* in_sizes, int n_in, void* d_out, int out_size, void* d_ws, size_t ws_size,
                              hipStream_t stream) {
    static int grid = 0;
    if (grid == 0) {
        if (n_in != 20 || ws_size < WS_END) { fprintf(stderr, "kernel_launch: unexpected n_in %d / ws %zu\n", n_in, ws_size); grid = -1; return; }
        int dev = 0, cus = 0, per_cu = 0;
        hipGetDevice(&dev);
        hipDeviceGetAttribute(&cus, hipDeviceAttributeMultiprocessorCount, dev);
#if MEGA
        hipFuncSetAttribute((const void*)mega_kernel, hipFuncAttributeMaxDynamicSharedMemorySize, LDS_BYTES);
        hipOccupancyMaxActiveBlocksPerMultiprocessor(&per_cu, (const void*)mega_kernel, NTHREADS, LDS_BYTES);
#else
        per_cu = 2;
#endif
        if (per_cu < 1) { fprintf(stderr, "kernel_launch: occupancy query %d\n", per_cu); per_cu = 1; }
        grid = cus * (per_cu < 2 ? per_cu : 2);
    }
    if (grid < 0) return;
    Params p{};
    p.x_p = (const float*)d_in[0]; p.x_s = (const float*)d_in[1]; p.c_p = (const float*)d_in[2]; p.c_s = (const float*)d_in[3];
    p.cache_m = (const float*)d_in[4]; p.cache_n = (const float*)d_in[5]; p.win_state = (const float*)d_in[6];
    p.page_table = (const int*)d_in[7];
    p.w_ada = (const float*)d_in[8]; p.b_ada = (const float*)d_in[9]; p.norm_gain = (const float*)d_in[10]; p.w_in = (const float*)d_in[11];
    p.cmp_pe = (const float*)d_in[12]; p.k_w1 = (const float*)d_in[13]; p.k_w2 = (const float*)d_in[14]; p.v_w1 = (const float*)d_in[15];
    p.v_w2 = (const float*)d_in[16]; p.w_out = (const float*)d_in[17]; p.rel_bias = (const float*)d_in[18]; p.final_gain = (const float*)d_in[19];
    p.out = (float*)d_out; p.ws = (unsigned char*)d_ws;
    hipMemsetAsync(d_ws, 0, WS_ZERO_BYTES, stream);
#if MEGA
    hipLaunchKernelGGL(mega_kernel, dim3(grid), dim3(NTHREADS), LDS_BYTES, stream, p);
#else
    hipLaunchKernelGGL(phase_kernel<0>, dim3(grid), dim3(NTHREADS), LDS_BYTES, stream, p);
    hipLaunchKernelGGL(phase_kernel<1>, dim3(grid), dim3(NTHREADS), LDS_BYTES, stream, p);
    hipLaunchKernelGGL(phase_kernel<2>, dim3(grid), dim3(NTHREADS), LDS_BYTES, stream, p);
    hipLaunchKernelGGL(phase_kernel<3>, dim3(grid), dim3(NTHREADS), LDS_BYTES, stream, p);
    hipLaunchKernelGGL(phase_kernel<4>, dim3(grid), dim3(NTHREADS), LDS_BYTES, stream, p);
    hipLaunchKernelGGL(phase_kernel<5>, dim3(grid), dim3(NTHREADS), LDS_BYTES, stream, p);
    hipLaunchKernelGGL(phase_kernel<6>, dim3(grid), dim3(NTHREADS), LDS_BYTES, stream, p);
#endif
}
```
